# Optimizing an MI355X kernel written in HIP

```python
import jax, jax.numpy as jnp
from jax import lax
import numpy as np

D_MODEL = 1024
BATCH = 4
SEQ = 8192
DEPTH = 2

N_META = 16
PAD = 128
BLOCK_Q = 128
EPS = 1e-6
NEG = -1e30

FOX_HEADS = 8
FOX_DH = 64
FOX_WIDTH = FOX_HEADS * FOX_DH
GLA_HEADS = 4
GLA_DK = 64
GLA_DV = 128
GLA_KW = GLA_HEADS * GLA_DK
GLA_WIDTH = GLA_HEADS * GLA_DV
GLA_RANK = 16
GLA_GATE_NORM = 16.0
GLA_CHUNK = 16
LRU_WIDTH = 2 * GLA_WIDTH
LRU_BLOCKS = 8
LRU_BS = LRU_WIDTH // LRU_BLOCKS
CONV_W = 4
LRU_C = 8.0

D_MIX = FOX_WIDTH + GLA_WIDTH + LRU_WIDTH
COL_SIZES = (FOX_WIDTH, FOX_WIDTH, FOX_WIDTH, FOX_HEADS, FOX_WIDTH,
             GLA_KW, GLA_KW, GLA_WIDTH, GLA_RANK, GLA_WIDTH,
             LRU_WIDTH, LRU_WIDTH)
D_IN = 3 * FOX_WIDTH + FOX_HEADS + FOX_WIDTH + 2 * GLA_KW + GLA_WIDTH + GLA_RANK + GLA_WIDTH + 2 * LRU_WIDTH

kernel_name = "hybrid_fox_gla_rglru_parallel_heads"


def rms_norm(x, g):
    xf = x.astype(jnp.float32)
    y = xf * lax.rsqrt(jnp.mean(xf * xf, axis=-1, keepdims=True) + EPS)
    return (y * g.astype(jnp.float32)).astype(x.dtype)


def split_projection(proj):
    offs = []
    acc = 0
    for s in COL_SIZES[:-1]:
        acc += s
        offs.append(acc)
    return jnp.split(proj, offs, axis=-1)


def fox_attention(q, k, v, log_f, valid):
    B, L, H, dh = q.shape
    nb = L // BLOCK_Q
    scale = dh ** -0.5
    c = jnp.cumsum(log_f, axis=1).transpose(0, 2, 1)
    kf = k.astype(jnp.float32).transpose(0, 2, 1, 3)
    vf = v.astype(jnp.float32).transpose(0, 2, 1, 3)
    qb = q.astype(jnp.float32).reshape(B, nb, BLOCK_Q, H, dh).transpose(1, 0, 3, 2, 4)
    cqb = c.reshape(B, H, nb, BLOCK_Q).transpose(2, 0, 1, 3)
    kpos = jnp.arange(L)

    def one_block(args):
        qi, cqi, i = args
        qpos = i * BLOCK_Q + jnp.arange(BLOCK_Q)
        s = jnp.einsum('bhqd,bhkd->bhqk', qi, kf) * scale + cqi[..., None] - c[:, :, None, :]
        mask = (kpos[None, :] <= qpos[:, None]) & valid[None, :]
        p = jax.nn.softmax(jnp.where(mask, s, NEG), axis=-1)
        return jnp.einsum('bhqk,bhkd->bhqd', p, vf)

    o = lax.map(one_block, (qb, cqb, jnp.arange(nb)))
    return o.transpose(1, 0, 3, 2, 4).reshape(B, L, H * dh)


def gla_chunked(q, k, v, log_a):
    B, L, H, dk = q.shape
    dv = v.shape[-1]
    C = GLA_CHUNK
    n = L // C

    def chunks(t):
        return t.astype(jnp.float32).reshape(B, n, C, H, t.shape[-1]).transpose(0, 3, 1, 2, 4)

    qc = chunks(q) * (dk ** -0.5)
    kc, vc, gc = chunks(k), chunks(v), chunks(log_a)
    b = jnp.cumsum(gc, axis=3)
    b_last = b[:, :, :, -1:, :]
    causal = jnp.tril(jnp.ones((C, C), dtype=bool))[:, :, None]
    diff = b[:, :, :, :, None, :] - b[:, :, :, None, :, :]
    decay = jnp.where(causal, jnp.exp(jnp.where(causal, diff, 0.0)), 0.0)
    A = jnp.einsum('bhntd,bhnsd,bhntsd->bhnts', qc, kc, decay)
    o_intra = jnp.einsum('bhnts,bhnsv->bhntv', A, vc)
    U = jnp.einsum('bhnsd,bhnsv->bhndv', kc * jnp.exp(b_last - b), vc)
    chunk_decay = jnp.exp(b_last[:, :, :, 0, :])

    def step(S, inp):
        u, dcy = inp
        return dcy[..., None] * S + u, S

    _, S_prev = lax.scan(step, jnp.zeros((B, H, dk, dv), jnp.float32),
                         (U.transpose(2, 0, 1, 3, 4), chunk_decay.transpose(2, 0, 1, 3)))
    S_prev = S_prev.transpose(1, 2, 0, 3, 4)
    o_inter = jnp.einsum('bhntd,bhndv->bhntv', qc * jnp.exp(b), S_prev)
    o = o_intra + o_inter
    return o.transpose(0, 2, 3, 1, 4).reshape(B, L, H, dv)


def causal_depthwise_conv(x, w, b):
    W = x.shape[-1]
    y = lax.conv_general_dilated(x, w[:, None, :].astype(x.dtype), window_strides=(1,),
                                 padding=[(CONV_W - 1, 0)],
                                 dimension_numbers=('NWC', 'WIO', 'NWC'),
                                 feature_group_count=W)
    return y + b.astype(x.dtype)


def rg_lru(xc, w_r, b_r, w_i, b_i, lam):
    B, L, W = xc.shape
    xb = xc.reshape(B, L, LRU_BLOCKS, LRU_BS)
    r = jax.nn.sigmoid(jnp.einsum('blhi,hij->blhj', xb, w_r).reshape(B, L, W).astype(jnp.float32) + b_r)
    i = jax.nn.sigmoid(jnp.einsum('blhi,hij->blhj', xb, w_i).reshape(B, L, W).astype(jnp.float32) + b_i)
    log_a = -LRU_C * r * jax.nn.softplus(-lam.astype(jnp.float32))
    a = jnp.exp(log_a)
    u = jnp.sqrt(-jnp.expm1(2.0 * log_a)) * (i * xc.astype(jnp.float32))

    def combine(left, right):
        a1, b1 = left
        a2, b2 = right
        return a1 * a2, a2 * b1 + b2

    _, h = lax.associative_scan(combine, (a, u), axis=1)
    return h


def setup_inputs(seed: int = 0) -> dict:
    key = jax.random.key(seed)
    ks = jax.random.split(key, 20)
    f32 = jnp.float32
    nrm = lambda k, shape, s: jax.random.normal(k, shape, f32) * s
    a0 = jax.random.uniform(ks[14], (DEPTH, LRU_WIDTH), f32, 0.9, 0.999)
    a_root = a0 ** (1.0 / LRU_C)
    return {
        "x": nrm(ks[0], (BATCH, SEQ, D_MODEL), 1.0),
        "meta": nrm(ks[1], (N_META, D_MODEL), 1.0),
        "pre_g": 1.0 + nrm(ks[2], (DEPTH, D_MODEL), 0.02),
        "w_in": nrm(ks[3], (DEPTH, D_MODEL, D_IN), D_MODEL ** -0.5),
        "b_f": jax.random.uniform(ks[4], (DEPTH, FOX_HEADS), f32, 1.0, 4.0),
        "w_a2": nrm(ks[5], (DEPTH, GLA_RANK, GLA_KW), GLA_RANK ** -0.5),
        "b_a": nrm(ks[6], (DEPTH, GLA_KW), 0.1),
        "gla_norm_g": 1.0 + nrm(ks[7], (DEPTH, GLA_WIDTH), 0.02),
        "conv_w": nrm(ks[8], (DEPTH, CONV_W, LRU_WIDTH), CONV_W ** -0.5),
        "conv_b": nrm(ks[9], (DEPTH, LRU_WIDTH), 0.02),
        "w_r": nrm(ks[10], (DEPTH, LRU_BLOCKS, LRU_BS, LRU_BS), LRU_BS ** -0.5),
        "b_r": nrm(ks[11], (DEPTH, LRU_WIDTH), 0.02),
        "w_i": nrm(ks[12], (DEPTH, LRU_BLOCKS, LRU_BS, LRU_BS), LRU_BS ** -0.5),
        "b_i": nrm(ks[13], (DEPTH, LRU_WIDTH), 0.02),
        "lru_lambda": jnp.log(a_root) - jnp.log1p(-a_root),
        "w_out": nrm(ks[15], (DEPTH, D_MIX, D_MODEL), D_MIX ** -0.5),
        "post_g": 1.0 + nrm(ks[16], (DEPTH, D_MODEL), 0.02),
    }


def reference(x, meta, pre_g, w_in, b_f, w_a2, b_a, gla_norm_g, conv_w, conv_b,
              w_r, b_r, w_i, b_i, lru_lambda, w_out, post_g):
    B, S, D = x.shape
    dt = x.dtype
    L = S + PAD
    h = jnp.concatenate([jnp.zeros((B, PAD - N_META, D), dt),
                         jnp.broadcast_to(meta.astype(dt)[None], (B, N_META, D)), x], axis=1)
    valid = jnp.arange(L) >= (PAD - N_META)
    vmask = valid[None, :, None].astype(dt)

    for l in range(DEPTH):
        hn = rms_norm(h, pre_g[l])
        proj = hn @ w_in[l]
        (fq, fk, fv, ff, fg, gq, gk, gv, ga, gg, lx, lg) = split_projection(proj)

        log_f = jax.nn.log_sigmoid(ff.astype(jnp.float32) + b_f[l]) * valid[None, :, None]
        o_fox = fox_attention(fq.reshape(B, L, FOX_HEADS, FOX_DH), fk.reshape(B, L, FOX_HEADS, FOX_DH),
                              fv.reshape(B, L, FOX_HEADS, FOX_DH), log_f, valid)
        y_fox = o_fox.astype(dt) * jax.nn.silu(fg)

        log_a = jax.nn.log_sigmoid((ga @ w_a2[l]).astype(jnp.float32) + b_a[l]) / GLA_GATE_NORM
        o_gla = gla_chunked(gq.reshape(B, L, GLA_HEADS, GLA_DK),
                            (gk * vmask).reshape(B, L, GLA_HEADS, GLA_DK),
                            gv.reshape(B, L, GLA_HEADS, GLA_DV),
                            log_a.reshape(B, L, GLA_HEADS, GLA_DK))
        o_gla = o_gla * lax.rsqrt(jnp.mean(o_gla * o_gla, axis=-1, keepdims=True) + EPS)
        o_gla = o_gla.reshape(B, L, GLA_WIDTH) * gla_norm_g[l].astype(jnp.float32)
        y_gla = o_gla.astype(dt) * jax.nn.silu(gg)

        xc = causal_depthwise_conv(lx, conv_w[l], conv_b[l]) * vmask
        h_lru = rg_lru(xc, w_r[l], b_r[l], w_i[l], b_i[l], lru_lambda[l])
        y_lru = h_lru.astype(dt) * jax.nn.silu(lg)

        y = jnp.concatenate([y_fox, y_gla, y_lru], axis=-1) * vmask
        h = h + rms_norm(y @ w_out[l], post_g[l])

    return h[:, PAD:]
```

```cpp
#include <hip/hip_runtime.h>
#include <hip/hip_cooperative_groups.h>
#include <cstdio>
namespace cg = cooperative_groups;

#define PROBE_G 0
#define PROBE_M1 0
#ifndef MEGA
#define MEGA 1
#endif

typedef unsigned short bf16_t;
typedef __attribute__((ext_vector_type(8))) short bfx8;
typedef __attribute__((ext_vector_type(16))) float f32x16;
typedef __attribute__((ext_vector_type(4))) float f32x4;
typedef __attribute__((ext_vector_type(4))) unsigned int u32x4;
typedef __attribute__((ext_vector_type(2))) unsigned int u32x2;
#define SMEM_BYTES 73728

#define NB 4
#define LSEQ 8320
#define SEQ 8192
#define NTOK 33280
#define DM 1024
#define DIN 5656
#define DMIX 2048
#define TV0 112
#define PADR 128

#define C_FQ 0
#define C_FK 512
#define C_FV 1024
#define C_FF 1536
#define C_FG 1544
#define C_GQ 2056
#define C_GK 2312
#define C_GV 2568
#define C_GA 3080
#define C_GG 3096
#define C_LX 3608
#define C_LG 4632
#define C_YF C_FQ
#define C_YG C_GV
#define C_YL C_LG

struct Prm {
  const float *x, *meta, *pre_g, *w_in, *b_f, *w_a2, *b_a, *gla_g, *conv_w, *conv_b;
  const float *w_r, *b_r, *w_i, *b_i, *lam, *w_out, *post_g;
  float* out;
  bf16_t* proj;
  bf16_t* r1;
  float* cfox;
  float* hmeta;
  bf16_t* wt_in;
  bf16_t* wt_out;
  bf16_t* wt_r;
  bf16_t* wt_i;
  float* lruP;
  float* lruH;
  bf16_t* gstate;
  float* gdec;
  unsigned* bar;
  float* fsum;
  float* gB;
  float* fnorm;
};

__device__ __forceinline__ float bf2f(bf16_t x) { return __uint_as_float(((unsigned)x) << 16); }
__device__ __forceinline__ bf16_t f2bf(float f) {
  unsigned u = __float_as_uint(f);
  u += 0x7fffu + ((u >> 16) & 1u);
  return (bf16_t)(u >> 16);
}
__device__ __forceinline__ unsigned pack2(float a, float b) { unsigned r; asm("v_cvt_pk_bf16_f32 %0, %1, %2" : "=v"(r) : "v"(a), "v"(b)); return r; }
__device__ __forceinline__ float wave_sum(float v) {
#pragma unroll
  for (int m = 32; m >= 1; m >>= 1) v += __shfl_xor(v, m);
  return v;
}
__device__ __forceinline__ float wave_max(float v) {
#pragma unroll
  for (int m = 32; m >= 1; m >>= 1) v = fmaxf(v, __shfl_xor(v, m));
  return v;
}
__device__ __forceinline__ float sigmoidf_(float x) { return __builtin_amdgcn_rcpf(1.f + __builtin_amdgcn_exp2f(-1.4426950408889634f * x)); }
__device__ __forceinline__ float siluf_(float x) { return x * sigmoidf_(x); }
__device__ __forceinline__ float logsigf_(float x) { return fminf(x, 0.f) - 0.6931471805599453f * __builtin_amdgcn_logf(1.f + __builtin_amdgcn_exp2f(-1.4426950408889634f * fabsf(x))); }
__device__ __forceinline__ float fexpf_(float x) { return __builtin_amdgcn_exp2f(1.4426950408889634f * x); }

__device__ __forceinline__ const float* h_src_row(const Prm& p, int layer, int b, int t) {
  if (t < TV0) return nullptr;
  if (layer == 0) return t < PADR ? p.meta + (size_t)(t - TV0) * DM : p.x + ((size_t)b * SEQ + (t - PADR)) * DM;
  return t < PADR ? p.hmeta + ((size_t)b * 16 + (t - TV0)) * DM : p.out + ((size_t)b * SEQ + (t - PADR)) * DM;
}

__device__ __forceinline__ void ph_prenorm0(const Prm& p) {
  const int lane = threadIdx.x & 63;
  const int wave = (blockIdx.x * blockDim.x + threadIdx.x) >> 6;
  const int nw = (gridDim.x * blockDim.x) >> 6;
  for (int row = wave; row < NTOK; row += nw) {
    int b = row / LSEQ, t = row % LSEQ;
    auto dstp = [&](int i) { const int k = (lane + 64 * i) * 4; return (uint2*)(p.r1 + ((size_t)(k >> 5) * NTOK + row) * 32 + (k & 31)); };
    const float* src = h_src_row(p, 0, b, t);
    if (!src) {
#pragma unroll
      for (int i = 0; i < 4; i++) *dstp(i) = make_uint2(0u, 0u);
      continue;
    }
    float4 v[4]; float ss = 0.f;
#pragma unroll
    for (int i = 0; i < 4; i++) {
      v[i] = ((const float4*)src)[lane + 64 * i];
      ss += v[i].x * v[i].x + v[i].y * v[i].y + v[i].z * v[i].z + v[i].w * v[i].w;
    }
    ss = wave_sum(ss);
    float rs = rsqrtf(ss * (1.f / DM) + 1e-6f);
#pragma unroll
    for (int i = 0; i < 4; i++) {
      float4 g = ((const float4*)p.pre_g)[lane + 64 * i];
      *dstp(i) = make_uint2(pack2(v[i].x * rs * g.x, v[i].y * rs * g.y), pack2(v[i].z * rs * g.z, v[i].w * rs * g.w));
    }
  }
}

__device__ __forceinline__ void ph_post(const Prm& p, int layer) {
  const int lane = threadIdx.x & 63;
  const int wave = (blockIdx.x * blockDim.x + threadIdx.x) >> 6;
  const int nw = (gridDim.x * blockDim.x) >> 6;
  const float* pg = p.post_g + layer * DM;
  for (int row = wave; row < NTOK; row += nw) {
    int b = row / LSEQ, t = row % LSEQ;
    auto zrp = [&](int i) { const int k = (lane + 64 * i) * 4; return (uint2*)(p.r1 + ((size_t)(k >> 5) * NTOK + row) * 32 + (k & 31)); };
    if (t < TV0) {
      if (layer == 0) {
#pragma unroll
        for (int i = 0; i < 4; i++) *zrp(i) = make_uint2(0u, 0u);
      }
      continue;
    }
    float4 z[4]; float ss = 0.f;
#pragma unroll
    for (int i = 0; i < 4; i++) {
      uint2 u = *zrp(i);
      z[i].x = __uint_as_float(u.x << 16); z[i].y = __uint_as_float(u.x & 0xffff0000u);
      z[i].z = __uint_as_float(u.y << 16); z[i].w = __uint_as_float(u.y & 0xffff0000u);
      ss += z[i].x * z[i].x + z[i].y * z[i].y + z[i].z * z[i].z + z[i].w * z[i].w;
    }
    ss = wave_sum(ss);
    float rs = rsqrtf(ss * (1.f / DM) + 1e-6f);
    const float* hs = h_src_row(p, layer, b, t);
    float ss2 = 0.f;
#pragma unroll
    for (int i = 0; i < 4; i++) {
      float4 g = ((const float4*)pg)[lane + 64 * i];
      float4 h = ((const float4*)hs)[lane + 64 * i];
      z[i].x = h.x + z[i].x * rs * g.x; z[i].y = h.y + z[i].y * rs * g.y;
      z[i].z = h.z + z[i].z * rs * g.z; z[i].w = h.w + z[i].w * rs * g.w;
      ss2 += z[i].x * z[i].x + z[i].y * z[i].y + z[i].z * z[i].z + z[i].w * z[i].w;
    }
    if (layer == 0) {
      float* hd = t < PADR ? p.hmeta + ((size_t)b * 16 + (t - TV0)) * DM : p.out + ((size_t)b * SEQ + (t - PADR)) * DM;
#pragma unroll
      for (int i = 0; i < 4; i++) ((float4*)hd)[lane + 64 * i] = z[i];
      ss2 = wave_sum(ss2);
      float rs2 = rsqrtf(ss2 * (1.f / DM) + 1e-6f);
      const float* g1 = p.pre_g + DM;
#pragma unroll
      for (int i = 0; i < 4; i++) {
        float4 g = ((const float4*)g1)[lane + 64 * i];
        *zrp(i) = make_uint2(pack2(z[i].x * rs2 * g.x, z[i].y * rs2 * g.y), pack2(z[i].z * rs2 * g.z, z[i].w * rs2 * g.w));
      }
    } else if (t >= PADR) {
      float* hd = p.out + ((size_t)b * SEQ + (t - PADR)) * DM;
#pragma unroll
      for (int i = 0; i < 4; i++) ((float4*)hd)[lane + 64 * i] = z[i];
    }
  }
}

__device__ __forceinline__ int ycol(int k) { return k < 512 ? C_YF + k : (k < 1024 ? C_YG + (k - 512) : C_YL + (k - 1024)); }

__device__ __forceinline__ void ph_gemm_naive(const bf16_t* A, int lda, bool remap, const float* W, int N, int K, bf16_t* C, int ldc, float* smem) {
  float (*As)[68] = (float (*)[68])smem;
  float (*Bs)[68] = (float (*)[68])(smem + 16 * 68);
  const int tid = threadIdx.x, tx = tid & 15, ty = tid >> 4;
  const int ntn = (N + 63) / 64, ntm = NTOK / 64;
  for (int tile = blockIdx.x; tile < ntn * ntm; tile += gridDim.x) {
    int m0 = (tile / ntn) * 64, n0 = (tile % ntn) * 64;
    float acc[4][4] = {};
    for (int k0 = 0; k0 < K; k0 += 16) {
      {
        int m = tid >> 2, kk = (tid & 3) * 4;
        int kc = remap ? ycol(k0 + kk) : k0 + kk;
        uint2 u = *(const uint2*)(A + (size_t)(m0 + m) * lda + kc);
        As[kk + 0][m] = __uint_as_float(u.x << 16); As[kk + 1][m] = __uint_as_float(u.x & 0xffff0000u);
        As[kk + 2][m] = __uint_as_float(u.y << 16); As[kk + 3][m] = __uint_as_float(u.y & 0xffff0000u);
        int kr = tid >> 4, nn = (tid & 15) * 4;
        float4 w = make_float4(0, 0, 0, 0);
        if (n0 + nn < N) w = *(const float4*)(W + (size_t)(k0 + kr) * N + n0 + nn);
        *(float4*)&Bs[kr][nn] = w;
      }
      __syncthreads();
#pragma unroll
      for (int k = 0; k < 16; k++) {
        float4 a = *(const float4*)&As[k][ty * 4];
        float4 b = *(const float4*)&Bs[k][tx * 4];
        float av[4] = {a.x, a.y, a.z, a.w}, bv[4] = {b.x, b.y, b.z, b.w};
#pragma unroll
        for (int i = 0; i < 4; i++)
#pragma unroll
          for (int j = 0; j < 4; j++) acc[i][j] += av[i] * bv[j];
      }
      __syncthreads();
    }
    if (n0 + tx * 4 < N) {
#pragma unroll
      for (int i = 0; i < 4; i++) {
        uint2 o = make_uint2(pack2(acc[i][0], acc[i][1]), pack2(acc[i][2], acc[i][3]));
        *(uint2*)(C + (size_t)(m0 + ty * 4 + i) * ldc + n0 + tx * 4) = o;
      }
    }
  }
}


__device__ __forceinline__ void ph_wtrans(const float* __restrict__ src0, int R, int Cc, bf16_t* __restrict__ dst0, float* smem, int bid, int nblk, int nmat = 1, int tiled = 0) {
  float (*tl)[33] = (float (*)[33])smem;
  const int tid = threadIdx.x, tx = tid & 31, ty = tid >> 5;
  const int ntc = (Cc + 31) / 32, ntr = R / 32;
  for (int tile0 = bid; tile0 < ntc * ntr * nmat; tile0 += nblk) {
    int mat = tile0 / (ntc * ntr), tile = tile0 % (ntc * ntr);
    const float* src = src0 + (size_t)mat * R * Cc;
    bf16_t* dst = dst0 + (size_t)mat * R * Cc;
    int r0 = (tile / ntc) * 32, c0 = (tile % ntc) * 32;
    __syncthreads();
#pragma unroll
    for (int i = 0; i < 4; i++) {
      int rr = ty + 8 * i;
      tl[rr][tx] = (c0 + tx < Cc) ? src[(size_t)(r0 + rr) * Cc + c0 + tx] : 0.f;
    }
    __syncthreads();
#pragma unroll
    for (int i = 0; i < 4; i++) {
      int cc = ty + 8 * i;
      if (c0 + cc < Cc) dst[tiled == 32 ? (((size_t)(r0 >> 5) * Cc + c0 + cc) * 32 + tx) : tiled == 64 ? (((size_t)(r0 >> 6) * Cc + c0 + cc) * 64 + (r0 & 63) + tx) : ((size_t)(c0 + cc) * R + r0 + tx)] = f2bf(tl[tx][cc]);
    }
  }
}

#define GLDS 72
template <bool REMAP>
__device__ __forceinline__ void ph_gemm_mfma(const bf16_t* __restrict__ A, int lda, const bf16_t* __restrict__ Wt, int N, int K,
                             bf16_t* __restrict__ C, int ldc, char* smem_raw) {
  bf16_t* sA = (bf16_t*)smem_raw;
  bf16_t* sB = sA + 128 * GLDS;
  int tid = threadIdx.x; asm volatile("" : "+v"(tid));
  const int lane = tid & 63, w = tid >> 6, wm = w & 1, wn = w >> 1;
  const int r = lane & 31, hh = lane >> 5;
  const int ntn = (N + 127) / 128, ntm = NTOK / 128;
  const int nk = K / 64;
  const int lrow = tid >> 3, lch = tid & 7;
#pragma unroll 1
  for (int tile = blockIdx.x; tile < ntm * ntn; tile += gridDim.x) {
    const int m0 = (tile / ntn) * 128, n0 = (tile % ntn) * 128;
    f32x16 acc[2][2];
#pragma unroll
    for (int a = 0; a < 2; a++)
#pragma unroll
      for (int b = 0; b < 2; b++)
#pragma unroll
        for (int e = 0; e < 16; e++) acc[a][b][e] = 0.f;
    u32x4 ra[4], rb[4];
#pragma unroll
    for (int i = 0; i < 4; i++) {
      int row = lrow + 32 * i;
      int kc = REMAP ? ycol(0) : 0;
      ra[i] = *(const u32x4*)(A + (size_t)(m0 + row) * lda + kc + lch * 8);
      int n = min(n0 + row, N - 1);
      rb[i] = *(const u32x4*)(Wt + (size_t)n * K + lch * 8);
    }
#pragma unroll 1
    for (int kt = 0; kt < nk; kt++) {
      __syncthreads();
#pragma unroll
      for (int i = 0; i < 4; i++) {
        int row = lrow + 32 * i;
        *(u32x4*)(sA + row * GLDS + lch * 8) = ra[i];
        *(u32x4*)(sB + row * GLDS + lch * 8) = rb[i];
      }
      __syncthreads();
      if (kt + 1 < nk) {
#pragma unroll
        for (int i = 0; i < 4; i++) {
          int row = lrow + 32 * i;
          int kc = REMAP ? ycol((kt + 1) * 64) : (kt + 1) * 64;
          ra[i] = *(const u32x4*)(A + (size_t)(m0 + row) * lda + kc + lch * 8);
          int n = min(n0 + row, N - 1);
          rb[i] = *(const u32x4*)(Wt + (size_t)n * K + (kt + 1) * 64 + lch * 8);
        }
      }
#pragma unroll
      for (int ks = 0; ks < 4; ks++) {
        const bfx8 a0 = *(const bfx8*)(sA + (wm * 64 + r) * GLDS + ks * 16 + hh * 8);
        const bfx8 a1 = *(const bfx8*)(sA + (wm * 64 + 32 + r) * GLDS + ks * 16 + hh * 8);
        const bfx8 b0 = *(const bfx8*)(sB + (wn * 64 + r) * GLDS + ks * 16 + hh * 8);
        const bfx8 b1 = *(const bfx8*)(sB + (wn * 64 + 32 + r) * GLDS + ks * 16 + hh * 8);
        acc[0][0] = __builtin_amdgcn_mfma_f32_32x32x16_bf16(b0, a0, acc[0][0], 0, 0, 0);
        acc[0][1] = __builtin_amdgcn_mfma_f32_32x32x16_bf16(b0, a1, acc[0][1], 0, 0, 0);
        acc[1][0] = __builtin_amdgcn_mfma_f32_32x32x16_bf16(b1, a0, acc[1][0], 0, 0, 0);
        acc[1][1] = __builtin_amdgcn_mfma_f32_32x32x16_bf16(b1, a1, acc[1][1], 0, 0, 0);
      }
    }
#pragma unroll
    for (int ni = 0; ni < 2; ni++)
#pragma unroll
      for (int mi = 0; mi < 2; mi++) {
        int m = m0 + wm * 64 + mi * 32 + r;
#pragma unroll
        for (int q = 0; q < 4; q++) {
          int n = n0 + wn * 64 + ni * 32 + 8 * q + 4 * hh;
          if (n < N) {
            uint2 o = make_uint2(pack2(acc[ni][mi][4 * q + 0], acc[ni][mi][4 * q + 1]), pack2(acc[ni][mi][4 * q + 2], acc[ni][mi][4 * q + 3]));
            *(uint2*)(C + (size_t)m * ldc + n) = o;
          }
        }
      }
  }
}


__device__ __forceinline__ void ph_gemm_big(const bf16_t* __restrict__ A, int lda, const bf16_t* __restrict__ Wt, int N, int K,
                             bf16_t* __restrict__ C, int ldc, char* smem_raw) {
  bf16_t* sA = (bf16_t*)smem_raw;
  bf16_t* sB = sA + 256 * GLDS;
  int tid = threadIdx.x; asm volatile("" : "+v"(tid));
  const int lane = tid & 63, w = tid >> 6, wm = w & 1, wn = w >> 1;
  const int r = lane & 31, hh = lane >> 5;
  const int ntn = (N + 127) / 128, ntm = NTOK / 256;
  const int nk = K / 64;
  const int lrow = tid >> 3, lch = tid & 7;
#pragma unroll 1
  for (int tile = blockIdx.x; tile < ntm * ntn; tile += gridDim.x) {
    const int m0 = (tile / ntn) * 256, n0 = (tile % ntn) * 128;
    f32x16 acc[2][4];
#pragma unroll
    for (int a = 0; a < 2; a++)
#pragma unroll
      for (int b = 0; b < 4; b++)
#pragma unroll
        for (int e = 0; e < 16; e++) acc[a][b][e] = 0.f;
    u32x4 ra[8], rb[4];
    const bf16_t* ap = A + (size_t)(m0 + lrow) * lda + lch * 8;
    const bf16_t* bp[4];
#pragma unroll
    for (int i = 0; i < 4; i++) bp[i] = Wt + (size_t)min(n0 + lrow + 32 * i, N - 1) * K + lch * 8;
#pragma unroll
    for (int i = 0; i < 8; i++) ra[i] = *(const u32x4*)(ap + (size_t)(32 * i) * lda);
#pragma unroll
    for (int i = 0; i < 4; i++) rb[i] = *(const u32x4*)(bp[i]);
#pragma unroll 1
    for (int kt = 0; kt < nk; kt++) {
      __syncthreads();
#pragma unroll
      for (int i = 0; i < 8; i++) *(u32x4*)(sA + (lrow + 32 * i) * GLDS + lch * 8) = ra[i];
#pragma unroll
      for (int i = 0; i < 4; i++) *(u32x4*)(sB + (lrow + 32 * i) * GLDS + lch * 8) = rb[i];
      __syncthreads();
      if (kt + 1 < nk) {
#pragma unroll
        for (int i = 0; i < 8; i++) ra[i] = *(const u32x4*)(ap + (size_t)(32 * i) * lda + (kt + 1) * 64);
#pragma unroll
        for (int i = 0; i < 4; i++) rb[i] = *(const u32x4*)(bp[i] + (kt + 1) * 64);
      }
#pragma unroll
      for (int ks = 0; ks < 4; ks++) {
        const bf16_t* xa = sA + (wm * 128 + r) * GLDS + ks * 16 + hh * 8;
        const bf16_t* wb = sB + (wn * 64 + r) * GLDS + ks * 16 + hh * 8;
        const bfx8 b0 = *(const bfx8*)(wb);
        const bfx8 b1 = *(const bfx8*)(wb + 32 * GLDS);
        const bfx8 a0 = *(const bfx8*)(xa);
        const bfx8 a1 = *(const bfx8*)(xa + 32 * GLDS);
        const bfx8 a2 = *(const bfx8*)(xa + 64 * GLDS);
        const bfx8 a3 = *(const bfx8*)(xa + 96 * GLDS);
        acc[0][0] = __builtin_amdgcn_mfma_f32_32x32x16_bf16(b0, a0, acc[0][0], 0, 0, 0);
        acc[1][0] = __builtin_amdgcn_mfma_f32_32x32x16_bf16(b1, a0, acc[1][0], 0, 0, 0);
        acc[0][1] = __builtin_amdgcn_mfma_f32_32x32x16_bf16(b0, a1, acc[0][1], 0, 0, 0);
        acc[1][1] = __builtin_amdgcn_mfma_f32_32x32x16_bf16(b1, a1, acc[1][1], 0, 0, 0);
        acc[0][2] = __builtin_amdgcn_mfma_f32_32x32x16_bf16(b0, a2, acc[0][2], 0, 0, 0);
        acc[1][2] = __builtin_amdgcn_mfma_f32_32x32x16_bf16(b1, a2, acc[1][2], 0, 0, 0);
        acc[0][3] = __builtin_amdgcn_mfma_f32_32x32x16_bf16(b0, a3, acc[0][3], 0, 0, 0);
        acc[1][3] = __builtin_amdgcn_mfma_f32_32x32x16_bf16(b1, a3, acc[1][3], 0, 0, 0);
      }
    }
#pragma unroll
    for (int ni = 0; ni < 2; ni++)
#pragma unroll
      for (int mi = 0; mi < 4; mi++) {
        int m = m0 + wm * 128 + mi * 32 + r;
#pragma unroll
        for (int q = 0; q < 4; q++) {
          int n = n0 + wn * 64 + ni * 32 + 8 * q + 4 * hh;
          if (n < N) {
            u32x2 o = {pack2(acc[ni][mi][4 * q + 0], acc[ni][mi][4 * q + 1]), pack2(acc[ni][mi][4 * q + 2], acc[ni][mi][4 * q + 3])};
            *(u32x2*)(C + (size_t)m * ldc + n) = o;
          }
        }
      }
  }
}


template <int MT, bool REMAP>
__device__ __forceinline__ void ph_gemm_glds(const bf16_t* __restrict__ A, int lda, const bf16_t* __restrict__ Wt, int N, int K,
                             bf16_t* __restrict__ C, int ldc, char* smem_raw) {
  constexpr int BM = MT * 64;
  constexpr int A_BYTES = BM * 64, B_BYTES = 128 * 64, STAGE = A_BYTES + B_BYTES;
  constexpr int NA = BM / 64;
  int tid = threadIdx.x; asm volatile("" : "+v"(tid));
  const int lane = tid & 63, w = __builtin_amdgcn_readfirstlane(tid >> 6), wm = w & 1, wn = w >> 1;
  const int r = lane & 31, hh = lane >> 5;
  const int ntn = (N + 127) / 128, ntm = NTOK / BM;
  const int nk = K / 32;
  const int gi = lane >> 2, gpiece = (lane & 3) ^ ((gi >> 2) & 3);
  const unsigned ldsbase = (unsigned)(size_t)smem_raw;
  const unsigned sw_ = (r >> 2) & 3;
  const unsigned ldsA0 = ldsbase + (wm * (MT * 32) + r) * 64 + ((hh ^ sw_) << 4);
  const unsigned ldsA1 = ldsbase + (wm * (MT * 32) + r) * 64 + (((2 + hh) ^ sw_) << 4);
  const unsigned ldsB0 = ldsbase + (wn * 64 + r) * 64 + ((hh ^ sw_) << 4);
  const unsigned ldsB1 = ldsbase + (wn * 64 + r) * 64 + (((2 + hh) ^ sw_) << 4);
  const int xcd = blockIdx.x & 7, cnt = (ntm - xcd + 7) >> 3, full = cnt >> 3, nslot = gridDim.x >> 3;
  int sq = blockIdx.x >> 3;
  int m0 = 0, n0 = 0;
  const bf16_t* ap[NA];
  const bf16_t* bp[2];
  const size_t akstep = (size_t)NTOK * 32, bkstep = (size_t)N * 32;
#define GEMM_TILE_SETUP(q_)                                                                                          \
  {                                                                                                                  \
    int g = (q_) / (8 * ntn), gm = 8, rem = (q_) - g * 8 * ntn;                                                      \
    if (g >= full) { g = full; gm = cnt - 8 * full; rem = (q_) - full * 8 * ntn; }                                   \
    const int nt_ = rem / gm, mi_ = rem - nt_ * gm;                                                                  \
    m0 = ((g * 8 + mi_) * 8 + xcd) * BM; n0 = nt_ * 128;                                                             \
    _Pragma("unroll") for (int i = 0; i < NA; i++)                                                                   \
      ap[i] = REMAP ? A + (size_t)(m0 + (w * NA + i) * 16 + gi) * lda + gpiece * 8                                   \
                    : A + (size_t)(m0 + (w * NA + i) * 16 + gi) * 32 + gpiece * 8;                                   \
    _Pragma("unroll") for (int i = 0; i < 2; i++)                                                                    \
      bp[i] = Wt + (size_t)min(n0 + (w * 2 + i) * 16 + gi, N - 1) * 32 + gpiece * 8;                                 \
    _Pragma("unroll") for (int st = 0; st < 2; st++) {                                                               \
      const size_t kc = REMAP ? (size_t)ycol(st * 32) : (size_t)st * akstep;                                         \
      char* nxt = smem_raw + st * STAGE;                                                                             \
      _Pragma("unroll") for (int i = 0; i < NA; i++)                                                                 \
        __builtin_amdgcn_global_load_lds((const unsigned*)(ap[i] + kc), (unsigned*)(nxt + (w * NA + i) * 1024), 16, 0, 0); \
      _Pragma("unroll") for (int i = 0; i < 2; i++)                                                                  \
        __builtin_amdgcn_global_load_lds((const unsigned*)(bp[i] + st * bkstep), (unsigned*)(nxt + A_BYTES + (w * 2 + i) * 1024), 16, 0, 0); \
    }                                                                                                                \
  }
  __syncthreads();
  if (sq < cnt * ntn) GEMM_TILE_SETUP(sq)
#pragma unroll 1
  while (sq < cnt * ntn) {
    const int cm0 = m0, cn0 = n0;
    f32x16 acc[2][MT];
#pragma unroll
    for (int a = 0; a < 2; a++)
#pragma unroll
      for (int b = 0; b < MT; b++)
#pragma unroll
        for (int e = 0; e < 16; e++) acc[a][b][e] = 0.f;
    int cb = 0;
#pragma unroll 1
    for (int kt = 0; kt < nk; kt++) {
      if (kt + 1 < nk) { if (NA == 4) asm volatile("s_waitcnt vmcnt(6)" ::: "memory"); else asm volatile("s_waitcnt vmcnt(4)" ::: "memory"); }
      else asm volatile("s_waitcnt vmcnt(0)" ::: "memory");
      __builtin_amdgcn_s_barrier();
      asm volatile("" ::: "memory");
      char* cur = smem_raw + cb * STAGE;
      cb = (cb == 2) ? 0 : cb + 1;
      bfx8 af[2][MT], bf[2][2];
      {
        const unsigned cofs = (unsigned)(cur - smem_raw);
        const unsigned aA0 = ldsA0 + cofs, aA1 = ldsA1 + cofs, aB0 = ldsB0 + cofs, aB1 = ldsB1 + cofs;
        asm volatile("ds_read_b128 %0, %1 offset:%2" : "=v"(bf[0][0]) : "v"(aB0), "n"(A_BYTES));
        asm volatile("ds_read_b128 %0, %1 offset:%2" : "=v"(bf[0][1]) : "v"(aB0), "n"(A_BYTES + 2048));
#pragma unroll
        for (int mi = 0; mi < MT; mi++) {
          if (mi == 0) asm volatile("ds_read_b128 %0, %1 offset:%2" : "=v"(af[0][0]) : "v"(aA0), "n"(0));
          if (mi == 1) asm volatile("ds_read_b128 %0, %1 offset:%2" : "=v"(af[0][1]) : "v"(aA0), "n"(2048));
          if (mi == 2) asm volatile("ds_read_b128 %0, %1 offset:%2" : "=v"(af[0][MT > 2 ? 2 : 0]) : "v"(aA0), "n"(4096));
          if (mi == 3) asm volatile("ds_read_b128 %0, %1 offset:%2" : "=v"(af[0][MT > 2 ? 3 : 0]) : "v"(aA0), "n"(6144));
        }
        asm volatile("ds_read_b128 %0, %1 offset:%2" : "=v"(bf[1][0]) : "v"(aB1), "n"(A_BYTES));
        asm volatile("ds_read_b128 %0, %1 offset:%2" : "=v"(bf[1][1]) : "v"(aB1), "n"(A_BYTES + 2048));
#pragma unroll
        for (int mi = 0; mi < MT; mi++) {
          if (mi == 0) asm volatile("ds_read_b128 %0, %1 offset:%2" : "=v"(af[1][0]) : "v"(aA1), "n"(0));
          if (mi == 1) asm volatile("ds_read_b128 %0, %1 offset:%2" : "=v"(af[1][1]) : "v"(aA1), "n"(2048));
          if (mi == 2) asm volatile("ds_read_b128 %0, %1 offset:%2" : "=v"(af[1][MT > 2 ? 2 : 0]) : "v"(aA1), "n"(4096));
          if (mi == 3) asm volatile("ds_read_b128 %0, %1 offset:%2" : "=v"(af[1][MT > 2 ? 3 : 0]) : "v"(aA1), "n"(6144));
        }
        if (kt + 2 < nk) {
          int nb = cb + 1; if (nb >= 3) nb -= 3;
          char* nxt = smem_raw + nb * STAGE;
          const size_t kc = REMAP ? (size_t)ycol((kt + 2) * 32) : (size_t)(kt + 2) * akstep;
  #pragma unroll
          for (int i = 0; i < NA; i++) __builtin_amdgcn_global_load_lds((const unsigned*)(ap[i] + kc), (unsigned*)(nxt + (w * NA + i) * 1024), 16, 0, 0);
  #pragma unroll
          for (int i = 0; i < 2; i++) __builtin_amdgcn_global_load_lds((const unsigned*)(bp[i] + (kt + 2) * bkstep), (unsigned*)(nxt + A_BYTES + (w * 2 + i) * 1024), 16, 0, 0);
        }
        if (MT == 4) asm volatile("s_waitcnt lgkmcnt(6)" : "+v"(bf[0][0]), "+v"(bf[0][1]), "+v"(af[0][0]), "+v"(af[0][1]), "+v"(af[0][MT > 2 ? 2 : 0]), "+v"(af[0][MT > 2 ? 3 : 1]));
        else asm volatile("s_waitcnt lgkmcnt(4)" : "+v"(bf[0][0]), "+v"(bf[0][1]), "+v"(af[0][0]), "+v"(af[0][1]));
#pragma unroll
        for (int mi = 0; mi < MT; mi++)
#pragma unroll
          for (int ni = 0; ni < 2; ni++)
            acc[ni][mi] = __builtin_amdgcn_mfma_f32_32x32x16_bf16(bf[0][ni], af[0][mi], acc[ni][mi], 0, 0, 0);
        __builtin_amdgcn_sched_barrier(0);
        if (MT == 4) asm volatile("s_waitcnt lgkmcnt(0)" : "+v"(bf[1][0]), "+v"(bf[1][1]), "+v"(af[1][0]), "+v"(af[1][1]), "+v"(af[1][MT > 2 ? 2 : 0]), "+v"(af[1][MT > 2 ? 3 : 1]));
        else asm volatile("s_waitcnt lgkmcnt(0)" : "+v"(bf[1][0]), "+v"(bf[1][1]), "+v"(af[1][0]), "+v"(af[1][1]));
#pragma unroll
        for (int mi = 0; mi < MT; mi++)
#pragma unroll
          for (int ni = 0; ni < 2; ni++)
            acc[ni][mi] = __builtin_amdgcn_mfma_f32_32x32x16_bf16(bf[1][ni], af[1][mi], acc[ni][mi], 0, 0, 0);
      }
      asm volatile("s_waitcnt lgkmcnt(0)" ::: "memory");
    }
    __syncthreads();
    sq += nslot;
    if (sq < cnt * ntn) GEMM_TILE_SETUP(sq)
    {
      char* cw = smem_raw + 2 * STAGE + w * (32 * 144);
      const int prow = lane >> 3, piece = lane & 7;
      const int n = cn0 + wn * 64 + piece * 8;
      const size_t crow = REMAP ? 32 : (size_t)ldc;
#pragma unroll
      for (int mi = 0; mi < MT; mi++) {
#pragma unroll
        for (int ni = 0; ni < 2; ni++)
#pragma unroll
          for (int q = 0; q < 4; q++) {
            u32x2 o = {pack2(acc[ni][mi][4 * q + 0], acc[ni][mi][4 * q + 1]), pack2(acc[ni][mi][4 * q + 2], acc[ni][mi][4 * q + 3])};
            *(u32x2*)(cw + r * 144 + (ni * 32 + 8 * q + 4 * hh) * 2) = o;
          }
        const int mrow = cm0 + wm * (MT * 32) + mi * 32 + prow;
        bf16_t* cp = REMAP ? C + ((size_t)(n >> 5) * NTOK + mrow) * 32 + (n & 31) : C + (size_t)mrow * ldc + n;
        if (n < N) {
#pragma unroll
          for (int j = 0; j < 4; j++) {
            const u32x4 v = *(const u32x4*)(cw + (j * 8 + prow) * 144 + piece * 16);
            *(u32x4*)(cp + (size_t)(j * 8) * crow) = v;
          }
        }
      }
    }
  }
#undef GEMM_TILE_SETUP
}


__device__ __forceinline__ void ph_gemm_out(const bf16_t* __restrict__ A, const bf16_t* __restrict__ Wt, bf16_t* __restrict__ C, char* smem_raw) {
  constexpr int N = DM, K = DMIX, lda = DIN;
  constexpr int A_BYTES = 128 * 128, STAGE = 2 * A_BYTES;
  int tid = threadIdx.x; asm volatile("" : "+v"(tid));
  const int lane = tid & 63, w = __builtin_amdgcn_readfirstlane(tid >> 6), wm = w & 1, wn = w >> 1;
  const int r = lane & 31, hh = lane >> 5;
  constexpr int ntn = N / 128, ntm = NTOK / 128, nk = K / 64;
  const int gi = lane >> 3, gpiece = (lane & 7) ^ gi;
  const unsigned ldsbase = (unsigned)(size_t)smem_raw;
  unsigned ldsA[4], ldsB[4];
#pragma unroll
  for (int ks = 0; ks < 4; ks++) {
    ldsA[ks] = ldsbase + (wm * 64 + r) * 128 + (((ks * 2 + hh) ^ (r & 7)) << 4);
    ldsB[ks] = ldsbase + A_BYTES + (wn * 64 + r) * 128 + (((ks * 2 + hh) ^ (r & 7)) << 4);
  }
  const int xcd = blockIdx.x & 7, cnt = (ntm - xcd + 7) >> 3, full = cnt >> 3, nslot = gridDim.x >> 3;
  int sq = blockIdx.x >> 3;
  int m0 = 0, n0 = 0;
  const bf16_t* ap[4];
  const bf16_t* bp[4];
#define OUT_TILE_COORD(q_)                                                                        \
  {                                                                                               \
    int g = (q_) / (8 * ntn), gm = 8, rem = (q_) - g * 8 * ntn;                                   \
    if (g >= full) { g = full; gm = cnt - 8 * full; rem = (q_) - full * 8 * ntn; }                \
    const int nt_ = rem / gm, mi_ = rem - nt_ * gm;                                               \
    m0 = ((g * 8 + mi_) * 8 + xcd) * 128; n0 = nt_ * 128;                                         \
    _Pragma("unroll") for (int i = 0; i < 4; i++) {                                               \
      ap[i] = A + (size_t)(m0 + (w * 4 + i) * 8 + gi) * lda + gpiece * 8;                         \
      bp[i] = Wt + (size_t)(n0 + (w * 4 + i) * 8 + gi) * 64 + gpiece * 8;                         \
    }                                                                                             \
  }
#define OUT_ISSUE(kt_, buf_)                                                                      \
  {                                                                                               \
    const int kc = ycol((kt_) * 64);                                                              \
    char* nxt = smem_raw + (buf_) * STAGE;                                                        \
    _Pragma("unroll") for (int i = 0; i < 4; i++)                                                 \
      __builtin_amdgcn_global_load_lds((const unsigned*)(ap[i] + kc), (unsigned*)(nxt + (w * 4 + i) * 1024), 16, 0, 0); \
    _Pragma("unroll") for (int i = 0; i < 4; i++)                                                 \
      __builtin_amdgcn_global_load_lds((const unsigned*)(bp[i] + (size_t)(kt_) * N * 64), (unsigned*)(nxt + A_BYTES + (w * 4 + i) * 1024), 16, 0, 0); \
  }
  __syncthreads();
  if (sq < cnt * ntn) { OUT_TILE_COORD(sq) OUT_ISSUE(0, 0) }
#pragma unroll 1
  while (sq < cnt * ntn) {
    const int cm0 = m0, cn0 = n0;
    f32x16 acc[2][2];
#pragma unroll
    for (int a = 0; a < 2; a++)
#pragma unroll
      for (int b = 0; b < 2; b++)
#pragma unroll
        for (int e = 0; e < 16; e++) acc[a][b][e] = 0.f;
#pragma unroll 1
    for (int kt = 0; kt < nk; kt++) {
      asm volatile("s_waitcnt vmcnt(0)" ::: "memory");
      __builtin_amdgcn_s_barrier();
      asm volatile("" ::: "memory");
      const unsigned cofs = (kt & 1) * STAGE;
      bfx8 af[4][2], bf[4][2];
#pragma unroll
      for (int ks = 0; ks < 4; ks++) {
        asm volatile("ds_read_b128 %0, %1 offset:%2" : "=v"(bf[ks][0]) : "v"(ldsB[ks] + cofs), "n"(0));
        asm volatile("ds_read_b128 %0, %1 offset:%2" : "=v"(bf[ks][1]) : "v"(ldsB[ks] + cofs), "n"(4096));
        asm volatile("ds_read_b128 %0, %1 offset:%2" : "=v"(af[ks][0]) : "v"(ldsA[ks] + cofs), "n"(0));
        asm volatile("ds_read_b128 %0, %1 offset:%2" : "=v"(af[ks][1]) : "v"(ldsA[ks] + cofs), "n"(4096));
      }
      if (kt + 1 < nk) OUT_ISSUE(kt + 1, (kt + 1) & 1)
      asm volatile("s_waitcnt lgkmcnt(8)" : "+v"(bf[0][0]), "+v"(bf[0][1]), "+v"(af[0][0]), "+v"(af[0][1]), "+v"(bf[1][0]), "+v"(bf[1][1]), "+v"(af[1][0]), "+v"(af[1][1]));
#pragma unroll
      for (int ks = 0; ks < 2; ks++)
#pragma unroll
        for (int mi = 0; mi < 2; mi++)
#pragma unroll
          for (int ni = 0; ni < 2; ni++)
            acc[ni][mi] = __builtin_amdgcn_mfma_f32_32x32x16_bf16(bf[ks][ni], af[ks][mi], acc[ni][mi], 0, 0, 0);
      __builtin_amdgcn_sched_barrier(0);
      asm volatile("s_waitcnt lgkmcnt(0)" : "+v"(bf[2][0]), "+v"(bf[2][1]), "+v"(af[2][0]), "+v"(af[2][1]), "+v"(bf[3][0]), "+v"(bf[3][1]), "+v"(af[3][0]), "+v"(af[3][1]));
#pragma unroll
      for (int ks = 2; ks < 4; ks++)
#pragma unroll
        for (int mi = 0; mi < 2; mi++)
#pragma unroll
          for (int ni = 0; ni < 2; ni++)
            acc[ni][mi] = __builtin_amdgcn_mfma_f32_32x32x16_bf16(bf[ks][ni], af[ks][mi], acc[ni][mi], 0, 0, 0);
    }
    __syncthreads();
    sq += nslot;
    if (sq < cnt * ntn) { OUT_TILE_COORD(sq) OUT_ISSUE(0, 0) }
    {
      char* cw = smem_raw + STAGE + w * (32 * 144);
      const int prow = lane >> 3, piece = lane & 7;
      const int n = cn0 + wn * 64 + piece * 8;
#pragma unroll
      for (int mi = 0; mi < 2; mi++) {
#pragma unroll
        for (int ni = 0; ni < 2; ni++)
#pragma unroll
          for (int q = 0; q < 4; q++) {
            u32x2 o = {pack2(acc[ni][mi][4 * q + 0], acc[ni][mi][4 * q + 1]), pack2(acc[ni][mi][4 * q + 2], acc[ni][mi][4 * q + 3])};
            *(u32x2*)(cw + r * 144 + (ni * 32 + 8 * q + 4 * hh) * 2) = o;
          }
        const int mrow = cm0 + wm * 64 + mi * 32 + prow;
        bf16_t* cp = C + ((size_t)(n >> 5) * NTOK + mrow) * 32 + (n & 31);
#pragma unroll
        for (int j = 0; j < 4; j++) {
          const u32x4 v = *(const u32x4*)(cw + (j * 8 + prow) * 144 + piece * 16);
          *(u32x4*)(cp + (size_t)(j * 8) * 32) = v;
        }
      }
    }
  }
#undef OUT_TILE_COORD
#undef OUT_ISSUE
}

__device__ __forceinline__ void ph_foxscan(const Prm& p, int layer) {
  const int lane = threadIdx.x & 63;
  const int wave = (blockIdx.x * blockDim.x + threadIdx.x) >> 6;
  const int nw = (gridDim.x * blockDim.x) >> 6;
  for (int it = wave; it < NB * 8; it += nw) {
    int b = it >> 3, h = it & 7;
    float bias = p.b_f[layer * 8 + h];
    float carry = 0.f;
    for (int t0 = 0; t0 < LSEQ; t0 += 64) {
      int t = t0 + lane;
      float lf = 0.f;
      if (t >= TV0) lf = logsigf_(bf2f(p.proj[(size_t)(b * LSEQ + t) * DIN + C_FF + h]) + bias);
#pragma unroll
      for (int off = 1; off < 64; off <<= 1) {
        float y = __shfl_up(lf, off);
        if (lane >= off) lf += y;
      }
      lf += carry;
      p.cfox[(size_t)it * LSEQ + t] = lf;
      carry = __shfl(lf, 63);
    }
  }
}

__device__ __forceinline__ void ph_fox_naive(const Prm& p, int bid, int nblk) {
  const int ngroups = NB * 8 * (LSEQ / 256) + NB * 8;
  const int gpb = (LSEQ + 255) / 256;
  (void)ngroups;
  for (int g = bid; g < NB * 8 * gpb; g += nblk) {
    int bh = g / gpb, tg = gpb - 1 - (g % gpb);
    int b = bh >> 3, h = bh & 7;
    int t = tg * 256 + threadIdx.x;
    if (t >= LSEQ) continue;
    bf16_t* qrow = p.proj + (size_t)(b * LSEQ + t) * DIN + C_FQ + h * 64;
    if (t < TV0) {
      for (int d = 0; d < 64; d++) qrow[d] = 0;
      continue;
    }
    float q[64], o[64];
#pragma unroll
    for (int d = 0; d < 64; d++) { q[d] = bf2f(qrow[d]) * 0.125f; o[d] = 0.f; }
    const float* cr = p.cfox + (size_t)bh * LSEQ;
    float ct = cr[t], m = -1e30f, l = 0.f;
    for (int s = TV0; s <= t; s++) {
      const uint4* kr = (const uint4*)(p.proj + (size_t)(b * LSEQ + s) * DIN + C_FK + h * 64);
      const uint4* vr = (const uint4*)(p.proj + (size_t)(b * LSEQ + s) * DIN + C_FV + h * 64);
      float dot = 0.f;
#pragma unroll
      for (int i = 0; i < 8; i++) {
        uint4 u = kr[i];
        dot += q[i * 8 + 0] * __uint_as_float(u.x << 16) + q[i * 8 + 1] * __uint_as_float(u.x & 0xffff0000u)
             + q[i * 8 + 2] * __uint_as_float(u.y << 16) + q[i * 8 + 3] * __uint_as_float(u.y & 0xffff0000u)
             + q[i * 8 + 4] * __uint_as_float(u.z << 16) + q[i * 8 + 5] * __uint_as_float(u.z & 0xffff0000u)
             + q[i * 8 + 6] * __uint_as_float(u.w << 16) + q[i * 8 + 7] * __uint_as_float(u.w & 0xffff0000u);
      }
      float sc = dot + ct - cr[s];
      float mn = fmaxf(m, sc);
      float al = __expf(m - mn), pe = __expf(sc - mn);
      l = l * al + pe; m = mn;
#pragma unroll
      for (int i = 0; i < 8; i++) {
        uint4 u = vr[i];
        o[i * 8 + 0] = o[i * 8 + 0] * al + pe * __uint_as_float(u.x << 16);
        o[i * 8 + 1] = o[i * 8 + 1] * al + pe * __uint_as_float(u.x & 0xffff0000u);
        o[i * 8 + 2] = o[i * 8 + 2] * al + pe * __uint_as_float(u.y << 16);
        o[i * 8 + 3] = o[i * 8 + 3] * al + pe * __uint_as_float(u.y & 0xffff0000u);
        o[i * 8 + 4] = o[i * 8 + 4] * al + pe * __uint_as_float(u.z << 16);
        o[i * 8 + 5] = o[i * 8 + 5] * al + pe * __uint_as_float(u.z & 0xffff0000u);
        o[i * 8 + 6] = o[i * 8 + 6] * al + pe * __uint_as_float(u.w << 16);
        o[i * 8 + 7] = o[i * 8 + 7] * al + pe * __uint_as_float(u.w & 0xffff0000u);
      }
    }
    float inv = 1.f / l;
    const bf16_t* grow = p.proj + (size_t)(b * LSEQ + t) * DIN + C_FG + h * 64;
#pragma unroll
    for (int d = 0; d < 64; d++) qrow[d] = f2bf(o[d] * inv * siluf_(bf2f(grow[d])));
  }
}

__device__ __forceinline__ void ph_gla_naive(const Prm& p, int layer, float* smem) {
  float (*sa)[64] = (float (*)[64])smem;
  float (*sq)[64] = (float (*)[64])(smem + 1024);
  float (*sk)[64] = (float (*)[64])(smem + 2048);
  float (*sred)[2] = (float (*)[2])(smem + 3072);
  const int tid = threadIdx.x;
  for (int it = blockIdx.x; it < NB * 4; it += gridDim.x) {
    int b = it >> 2, h = it & 3;
    float S[64];
#pragma unroll
    for (int d = 0; d < 64; d++) S[d] = 0.f;
    const float* wa = p.w_a2 + (size_t)layer * 16 * 256;
    const float* ba = p.b_a + layer * 256;
    float gn = (tid < 128) ? p.gla_g[layer * 512 + h * 128 + tid] : 0.f;
    for (int t0 = 0; t0 < LSEQ; t0 += 16) {
      __syncthreads();
      for (int e = tid; e < 1024; e += blockDim.x) {
        int tt = e >> 6, d = e & 63, t = t0 + tt;
        const bf16_t* row = p.proj + (size_t)(b * LSEQ + t) * DIN;
        float xa = ba[h * 64 + d];
#pragma unroll
        for (int r = 0; r < 16; r++) xa += bf2f(row[C_GA + r]) * wa[r * 256 + h * 64 + d];
        sa[tt][d] = __expf(logsigf_(xa) * (1.f / 16.f));
        sq[tt][d] = bf2f(row[C_GQ + h * 64 + d]) * 0.125f;
        sk[tt][d] = (t >= TV0) ? bf2f(row[C_GK + h * 64 + d]) : 0.f;
      }
      __syncthreads();
      float o[16];
      if (tid < 128) {
#pragma unroll
        for (int tt = 0; tt < 16; tt++) {
          float v = bf2f(p.proj[(size_t)(b * LSEQ + t0 + tt) * DIN + C_GV + h * 128 + tid]);
          float acc = 0.f;
#pragma unroll
          for (int d = 0; d < 64; d++) {
            S[d] = sa[tt][d] * S[d] + sk[tt][d] * v;
            acc += sq[tt][d] * S[d];
          }
          o[tt] = acc;
          float ssq = wave_sum(acc * acc);
          if ((tid & 63) == 0) sred[tt][tid >> 6] = ssq;
        }
      }
      __syncthreads();
      if (tid < 128) {
#pragma unroll
        for (int tt = 0; tt < 16; tt++) {
          int t = t0 + tt;
          float ms = (sred[tt][0] + sred[tt][1]) * (1.f / 128.f);
          bf16_t* row = p.proj + (size_t)(b * LSEQ + t) * DIN;
          float y = o[tt] * rsqrtf(ms + 1e-6f) * gn * siluf_(bf2f(row[C_GG + h * 128 + tid]));
          if (t < TV0) y = 0.f;
          row[C_YG + h * 128 + tid] = f2bf(y);
        }
      }
    }
  }
}

__device__ __forceinline__ void ph_lru_naive_b(const Prm& p, int layer, float* smem, int bid0) {
  float (*sx)[128] = (float (*)[128])smem;
  const int tid = threadIdx.x;
  for (int it = bid0; it < NB * 8; it += gridDim.x) {
    int b = it >> 3, hb = it & 7;
    int j = tid & 127, c = hb * 128 + j;
    const float* cw = p.conv_w + (size_t)layer * 4 * 1024;
    float w0 = cw[c], w1 = cw[1024 + c], w2 = cw[2048 + c], w3 = cw[3072 + c], cb = p.conv_b[layer * 1024 + c];
    float br = p.b_r[layer * 1024 + c], bi = p.b_i[layer * 1024 + c];
    float lamv = p.lam[layer * 1024 + c];
    float sp = fmaxf(-lamv, 0.f) + log1pf(__expf(-fabsf(lamv)));
    const float* wr = p.w_r + ((size_t)layer * 8 + hb) * 128 * 128;
    const float* wi = p.w_i + ((size_t)layer * 8 + hb) * 128 * 128;
    float x1 = 0.f, x2 = 0.f, x3 = 0.f, hst = 0.f;
    for (int t0 = 0; t0 < LSEQ; t0 += 8) {
      float xc[8];
      __syncthreads();
      if (tid < 128) {
#pragma unroll
        for (int tt = 0; tt < 8; tt++) {
          int t = t0 + tt;
          float x0 = bf2f(p.proj[(size_t)(b * LSEQ + t) * DIN + C_LX + c]);
          float v = w0 * x3 + w1 * x2 + w2 * x1 + w3 * x0 + cb;
          if (t < TV0) v = 0.f;
          x3 = x2; x2 = x1; x1 = x0;
          xc[tt] = v; sx[tt][j] = v;
        }
      }
      __syncthreads();
      if (tid < 128) {
        float ar[8], ai[8];
#pragma unroll
        for (int tt = 0; tt < 8; tt++) { ar[tt] = br; ai[tt] = bi; }
        for (int i = 0; i < 128; i++) {
          float a = wr[i * 128 + j], bb = wi[i * 128 + j];
#pragma unroll
          for (int tt = 0; tt < 8; tt++) { float xv = sx[tt][i]; ar[tt] += xv * a; ai[tt] += xv * bb; }
        }
#pragma unroll
        for (int tt = 0; tt < 8; tt++) {
          int t = t0 + tt;
          float r = sigmoidf_(ar[tt]), ig = sigmoidf_(ai[tt]);
          float la = -8.f * r * sp;
          float a = __expf(la);
          float u = sqrtf(-expm1f(2.f * la)) * (ig * xc[tt]);
          hst = a * hst + u;
          bf16_t* row = p.proj + (size_t)(b * LSEQ + t) * DIN;
          float y = hst * siluf_(bf2f(row[C_LG + c]));
          if (t < TV0) y = 0.f;
          row[C_YL + c] = f2bf(y);
        }
      }
    }
  }
}


#define NCH 130
#define LXS 136
template <bool PASSC>
__device__ __forceinline__ void ph_lru(const Prm& p, int layer, char* smem, const int item) {
  bf16_t* sX = (bf16_t*)smem;
  int tid = threadIdx.x; asm volatile("" : "+v"(tid));
  const int lane = tid & 63, w = tid >> 6, r = lane & 31, hh = lane >> 5;
  const int taur = 16 * ((r >> 2) & 1) + (r & 3) + 4 * (r >> 3);
  const int cp = tid & 63, tg = tid >> 6;
  {
    const int hb = item & 7, j = (item >> 3) % NCH, b = item / (8 * NCH);
    const int t0 = j * 64;
    __syncthreads();
    const int wrow = lane >> 4, wpc = lane & 15;
    const bf16_t* wgr = p.wt_r + ((size_t)(layer * 8 + hb) * 128 + w * 32 + wrow) * 128 + wpc * 8;
    const bf16_t* wgi = p.wt_i + ((size_t)(layer * 8 + hb) * 128 + w * 32 + wrow) * 128 + wpc * 8;
    bf16_t* sW = (bf16_t*)(smem + 64 * LXS * 2) + w * (32 * LXS);
    u32x4 wreg[8];
#pragma unroll
    for (int i = 0; i < 8; i++) wreg[i] = *(const u32x4*)(wgr + (size_t)(4 * i) * 128);
    {
      const int pc8 = tid & 15, tq4 = tid >> 4;
      const int c0 = hb * 128 + pc8 * 8;
      const float* cw = p.conv_w + (size_t)layer * 4 * 1024 + c0;
      float wv[4][8], cbv[8];
#pragma unroll
      for (int tp = 0; tp < 4; tp++) {
        const f32x4 wa = *(const f32x4*)(cw + tp * 1024), wb = *(const f32x4*)(cw + tp * 1024 + 4);
#pragma unroll
        for (int k = 0; k < 4; k++) { wv[tp][k] = wa[k]; wv[tp][4 + k] = wb[k]; }
      }
      {
        const f32x4 ba = *(const f32x4*)(p.conv_b + layer * 1024 + c0), bb = *(const f32x4*)(p.conv_b + layer * 1024 + c0 + 4);
#pragma unroll
        for (int k = 0; k < 4; k++) { cbv[k] = ba[k]; cbv[4 + k] = bb[k]; }
      }
      const int tb = t0 + tq4 * 4;
      const bf16_t* base = p.proj + (size_t)b * LSEQ * DIN + C_LX + c0;
      u32x4 xr[7];
#pragma unroll
      for (int i = 0; i < 7; i++) {
        const int t = tb - 3 + i;
        xr[i] = (t >= 0) ? *(const u32x4*)(base + (size_t)t * DIN) : (u32x4){0u, 0u, 0u, 0u};
      }
#pragma unroll
      for (int tt = 0; tt < 4; tt++) {
        u32x4 o;
#pragma unroll
        for (int k = 0; k < 4; k++) {
          typedef float f32x2c __attribute__((ext_vector_type(2)));
          f32x2c v = {cbv[2 * k], cbv[2 * k + 1]};
#pragma unroll
          for (int tp = 0; tp < 4; tp++) {
            const unsigned u = xr[tt + tp][k];
            const f32x2c x = {__uint_as_float(u << 16), __uint_as_float(u & 0xffff0000u)};
            const f32x2c wp = {wv[tp][2 * k], wv[tp][2 * k + 1]};
            v = wp * x + v;
          }
          o[k] = pack2(v[0], v[1]);
        }
        if (tb + tt < TV0) { o[0] = 0u; o[1] = 0u; o[2] = 0u; o[3] = 0u; }
        *(u32x4*)(sX + (tq4 * 4 + tt) * LXS + pc8 * 8) = o;
      }
    }
    __syncthreads();
    const int jc = w * 32 + r, c = hb * 128 + jc;
    f32x16 R0, R1, I0, I1;
#pragma unroll
    for (int e = 0; e < 16; e++) { R0[e] = 0.f; R1[e] = 0.f; I0[e] = 0.f; I1[e] = 0.f; }
    {
#pragma unroll
      for (int i = 0; i < 8; i++) *(u32x4*)(sW + (wrow + 4 * i) * LXS + wpc * 8) = wreg[i];
#pragma unroll
      for (int i = 0; i < 8; i++) wreg[i] = *(const u32x4*)(wgi + (size_t)(4 * i) * 128);
#pragma unroll
      for (int ks = 0; ks < 8; ks++) {
        const bfx8 bR = *(const bfx8*)(sW + r * LXS + ks * 16 + hh * 8);
        const bfx8 a0 = *(const bfx8*)(sX + taur * LXS + ks * 16 + hh * 8);
        const bfx8 a1 = *(const bfx8*)(sX + (32 + taur) * LXS + ks * 16 + hh * 8);
        R0 = __builtin_amdgcn_mfma_f32_32x32x16_bf16(a0, bR, R0, 0, 0, 0);
        R1 = __builtin_amdgcn_mfma_f32_32x32x16_bf16(a1, bR, R1, 0, 0, 0);
      }
      asm volatile("s_waitcnt lgkmcnt(0)" ::: "memory");
#pragma unroll
      for (int i = 0; i < 8; i++) *(u32x4*)(sW + (wrow + 4 * i) * LXS + wpc * 8) = wreg[i];
#pragma unroll
      for (int ks = 0; ks < 8; ks++) {
        const bfx8 bI = *(const bfx8*)(sW + r * LXS + ks * 16 + hh * 8);
        const bfx8 a0 = *(const bfx8*)(sX + taur * LXS + ks * 16 + hh * 8);
        const bfx8 a1 = *(const bfx8*)(sX + (32 + taur) * LXS + ks * 16 + hh * 8);
        I0 = __builtin_amdgcn_mfma_f32_32x32x16_bf16(a0, bI, I0, 0, 0, 0);
        I1 = __builtin_amdgcn_mfma_f32_32x32x16_bf16(a1, bI, I1, 0, 0, 0);
      }
    }
    const float br = p.b_r[layer * 1024 + c], bi = p.b_i[layer * 1024 + c];
    const float lamv = p.lam[layer * 1024 + c];
    const float sp8 = -8.f * 1.4426950408889634f * (fmaxf(-lamv, 0.f) + log1pf(__expf(-fabsf(lamv))));
    const float brl = -1.4426950408889634f * br, bil = -1.4426950408889634f * bi;
    typedef float f32x2 __attribute__((ext_vector_type(2)));
    f32x2 Pv = {1.f, 1.f}, Hv = {0.f, 0.f};
    const f32x2 nl2 = {-1.4426950408889634f, -1.4426950408889634f}, one2 = {1.f, 1.f};
    const f32x2 brl2 = {brl, brl}, bil2 = {bil, bil}, sp82 = {sp8, sp8};
#pragma unroll
    for (int e = 0; e < 16; e++) {
      const f32x2 Rv = {R0[e], R1[e]}, Iv = {I0[e], I1[e]};
      f32x2 er = Rv * nl2 + brl2, ei = Iv * nl2 + bil2;
      er = (f32x2){__builtin_amdgcn_exp2f(er[0]), __builtin_amdgcn_exp2f(er[1])} + one2;
      ei = (f32x2){__builtin_amdgcn_exp2f(ei[0]), __builtin_amdgcn_exp2f(ei[1])} + one2;
      const f32x2 rr = {__builtin_amdgcn_rcpf(er[0]), __builtin_amdgcn_rcpf(er[1])};
      const f32x2 ig = {__builtin_amdgcn_rcpf(ei[0]), __builtin_amdgcn_rcpf(ei[1])};
      const f32x2 la = rr * sp82;
      const f32x2 a = {__builtin_amdgcn_exp2f(la[0]), __builtin_amdgcn_exp2f(la[1])};
      const f32x2 xv = {bf2f(sX[(16 * hh + e) * LXS + jc]), bf2f(sX[(32 + 16 * hh + e) * LXS + jc])};
      const f32x2 om = one2 - a * a;
      const f32x2 sq = {__builtin_amdgcn_sqrtf(om[0]), __builtin_amdgcn_sqrtf(om[1])};
      const f32x2 u = sq * ig * xv;
      R0[e] = a[0]; R1[e] = a[1]; I0[e] = u[0]; I1[e] = u[1];
      Pv = Pv * a; Hv = a * Hv + u;
    }
    const float P0 = Pv[0], P1 = Pv[1], H0 = Hv[0], H1 = Hv[1];
    const float oP0 = __shfl_xor(P0, 32), oH0 = __shfl_xor(H0, 32), oP1 = __shfl_xor(P1, 32), oH1 = __shfl_xor(H1, 32);
    const float P00 = hh ? oP0 : P0, H00 = hh ? oH0 : H0, P01 = hh ? P0 : oP0, H01 = hh ? H0 : oH0;
    const float P10 = hh ? oP1 : P1, H10 = hh ? oH1 : H1, P11 = hh ? P1 : oP1, H11 = hh ? H1 : oH1;
    const size_t aidx = ((size_t)b * NCH + j) * 1024 + c;
    if (!PASSC) {
      if (hh == 0) {
        p.lruP[aidx] = P00 * P01 * P10 * P11;
        p.lruH[aidx] = ((H00 * P01 + H01) * P10 + H10) * P11 + H11;
      }
    } else {
      const float s00 = p.lruH[aidx];
      const float s01 = P00 * s00 + H00;
      const float s10 = P01 * s01 + H01;
      const float s11 = P10 * s10 + H10;
      float h0 = hh ? s01 : s00, h1 = hh ? s11 : s10;
      const int prow = tid >> 4, pc = tid & 15;
      bf16_t* ob = p.proj + ((size_t)b * LSEQ + t0 + prow) * DIN + hb * 128 + pc * 8;
      u32x4 lgv[4];
#pragma unroll
      for (int i = 0; i < 4; i++) lgv[i] = *(const u32x4*)(ob + (size_t)(16 * i) * DIN + C_LG);
      __syncthreads();
#pragma unroll
      for (int e = 0; e < 16; e++) {
        h0 = R0[e] * h0 + I0[e];
        h1 = R1[e] * h1 + I1[e];
        sX[(16 * hh + e) * LXS + jc] = f2bf(h0);
        sX[(32 + 16 * hh + e) * LXS + jc] = f2bf(h1);
      }
      __syncthreads();
#pragma unroll
      for (int i = 0; i < 4; i++) {
        const int row = prow + 16 * i;
        const u32x4 hv = *(const u32x4*)(sX + row * LXS + pc * 8);
        u32x4 o;
#pragma unroll
        for (int k = 0; k < 4; k++) {
          float ya = __uint_as_float(hv[k] << 16) * siluf_(__uint_as_float(lgv[i][k] << 16));
          float yb = __uint_as_float(hv[k] & 0xffff0000u) * siluf_(__uint_as_float(lgv[i][k] & 0xffff0000u));
          o[k] = pack2(ya, yb);
        }
        if (t0 + row < TV0) { o[0] = 0u; o[1] = 0u; o[2] = 0u; o[3] = 0u; }
        *(u32x4*)(ob + (size_t)(16 * i) * DIN + C_YL) = o;
      }
    }
  }
}

__device__ __forceinline__ void ph_lru_scan(const Prm& p, int gtid, int gthreads) {
  for (int i = gtid; i < NB * 1024; i += gthreads) {
    int b = i >> 10, c = i & 1023;
    float s = 0.f;
    size_t base = (size_t)b * NCH * 1024 + c;
    for (int j0 = 0; j0 < NCH; j0 += 13) {
      float Pv[13], Hv[13];
#pragma unroll
      for (int k = 0; k < 13; k++) { Pv[k] = p.lruP[base + (size_t)(j0 + k) * 1024]; Hv[k] = p.lruH[base + (size_t)(j0 + k) * 1024]; }
#pragma unroll
      for (int k = 0; k < 13; k++) { p.lruH[base + (size_t)(j0 + k) * 1024] = s; s = Pv[k] * s + Hv[k]; }
    }
  }
}


#define GS 72
template <bool PASSC>
__device__ __forceinline__ void ph_gla(const Prm& p, int layer, char* smem, const int item) {
  bf16_t* sQ = (bf16_t*)smem;
  bf16_t* sK = sQ + 64 * GS;
  bf16_t* sVt = sK + 64 * GS;
  bf16_t* sP = sVt + 128 * GS;
  bf16_t* sSt = sP + 64 * GS;
  float* sTot = (float*)(sSt + 128 * GS);
  float* sRed = sTot + 256;
  int tid = threadIdx.x; asm volatile("" : "+v"(tid));
  const int lane = tid & 63, w = tid >> 6, r = lane & 31, hh = lane >> 5;
  const int d = (w >> 1) * 32 + r, tg = (w & 1) * 2 + hh;
  {
    const int bh = item % 16, j = item / 16;
    const int b = bh >> 2, h = bh & 3;
    const int t0 = j * 64;
    const bf16_t* pb = p.proj + (size_t)(b * LSEQ + t0) * DIN;
    __syncthreads();
    float Bv[16];
    float* gBp = p.gB + (((size_t)bh * NCH + j) * 64 + tg * 16) * 64 + d;
    if (PASSC) {
#pragma unroll
      for (int tt = 0; tt < 16; tt++) Bv[tt] = gBp[tt * 64];
    } else {
      const int taur = 16 * ((r >> 2) & 1) + (r & 3) + 4 * (r >> 3);
      const bfx8 av = *(const bfx8*)(pb + (size_t)((w & 1) * 32 + taur) * DIN + C_GA + hh * 8);
      const float* wap = p.w_a2 + (size_t)layer * 16 * 256 + (size_t)(hh * 8) * 256 + h * 64 + d;
      union { bfx8 v; unsigned u[4]; } bw;
#pragma unroll
      for (int q = 0; q < 4; q++) bw.u[q] = pack2(wap[(2 * q) * 256], wap[(2 * q + 1) * 256]);
      f32x16 xg;
#pragma unroll
      for (int e = 0; e < 16; e++) xg[e] = 0.f;
      xg = __builtin_amdgcn_mfma_f32_32x32x16_bf16(av, bw.v, xg, 0, 0, 0);
      const float ba = p.b_a[layer * 256 + h * 64 + d];
      float cum = 0.f;
#pragma unroll
      for (int tt = 0; tt < 16; tt++) {
        cum += logsigf_(xg[tt] + ba) * (1.f / 16.f);
        Bv[tt] = cum;
      }
      sTot[tg * 64 + d] = cum;
    }
#pragma unroll
    for (int i = 0; i < 4; i++) {
      const int c8 = w + 4 * i, tk = tid & 63;
      u32x4 v = *(const u32x4*)(pb + (size_t)tk * DIN + C_GV + h * 128 + c8 * 8);
#pragma unroll
      for (int q = 0; q < 4; q++) {
        sVt[(c8 * 8 + 2 * q) * GS + tk] = (bf16_t)(v[q] & 0xffffu);
        sVt[(c8 * 8 + 2 * q + 1) * GS + tk] = (bf16_t)(v[q] >> 16);
      }
    }
    {
#pragma unroll
      for (int i = 0; i < 2; i++) {
        const int id = tid + 256 * i, row = id >> 3, ch = id & 7;
        *(u32x4*)(sK + row * GS + ch * 8) = *(const u32x4*)(pb + (size_t)row * DIN + C_GK + h * 64 + ch * 8);
        if (PASSC) *(u32x4*)(sQ + row * GS + ch * 8) = *(const u32x4*)(pb + (size_t)row * DIN + C_GQ + h * 64 + ch * 8);
      }
    }
    __syncthreads();
    float offs = 0.f, blast = 0.f;
    if (!PASSC) {
#pragma unroll
      for (int g = 0; g < 4; g++) { float v = sTot[g * 64 + d]; blast += v; if (g < tg) offs += v; }
#pragma unroll
      for (int tt = 0; tt < 16; tt++) gBp[tt * 64] = Bv[tt] + offs;
    }
    if (!PASSC) {
      unsigned pk[8];
#pragma unroll
      for (int tt = 0; tt < 16; tt += 2) {
        int ta = t0 + tg * 16 + tt;
        float k0 = (ta >= TV0) ? bf2f(sK[(tg * 16 + tt) * GS + d]) : 0.f;
        float k1 = (ta + 1 >= TV0) ? bf2f(sK[(tg * 16 + tt + 1) * GS + d]) : 0.f;
        pk[tt >> 1] = pack2(k0 * fexpf_(blast - (Bv[tt] + offs)), k1 * fexpf_(blast - (Bv[tt + 1] + offs)));
      }
      u32x4 o0 = {pk[0], pk[1], pk[2], pk[3]}, o1 = {pk[4], pk[5], pk[6], pk[7]};
      *(u32x4*)(sQ + d * GS + tg * 16) = o0;
      *(u32x4*)(sQ + d * GS + tg * 16 + 8) = o1;
      if (tg == 0) p.gdec[((size_t)bh * NCH + j) * 64 + d] = fexpf_(blast);
      __syncthreads();
      f32x16 a0, a1;
#pragma unroll
      for (int e = 0; e < 16; e++) { a0[e] = 0.f; a1[e] = 0.f; }
#pragma unroll
      for (int ks = 0; ks < 4; ks++) {
        const bfx8 av = *(const bfx8*)(sVt + (w * 32 + r) * GS + ks * 16 + hh * 8);
        const bfx8 b0 = *(const bfx8*)(sQ + r * GS + ks * 16 + hh * 8);
        const bfx8 b1 = *(const bfx8*)(sQ + (32 + r) * GS + ks * 16 + hh * 8);
        a0 = __builtin_amdgcn_mfma_f32_32x32x16_bf16(av, b0, a0, 0, 0, 0);
        a1 = __builtin_amdgcn_mfma_f32_32x32x16_bf16(av, b1, a1, 0, 0, 0);
      }
      bf16_t* gs = p.gstate + ((size_t)bh * NCH + j) * 8192;
#pragma unroll
      for (int e = 0; e < 16; e++) {
        int dv = w * 32 + (e & 3) + 8 * (e >> 2) + 4 * hh;
        gs[dv * 64 + r] = f2bf(a0[e]);
        gs[dv * 64 + 32 + r] = f2bf(a1[e]);
      }
    } else {
#pragma unroll
      for (int tt = 0; tt < 16; tt++) {
        typedef float f32x2g __attribute__((ext_vector_type(2)));
        const int tl = tg * 16 + tt, ta = t0 + tl;
        const float bl = Bv[tt] * 1.4426950408889634f;
        const f32x2g x = {bf2f(sQ[tl * GS + d]), (ta >= TV0) ? bf2f(sK[tl * GS + d]) : 0.f};
        const f32x2g e2 = {__builtin_amdgcn_exp2f(bl), __builtin_amdgcn_exp2f(-bl)};
        const f32x2g y = x * (f32x2g){0.125f, 1.f} * e2;
        const unsigned pk = pack2(y[0], y[1]);
        sQ[tl * GS + d] = (bf16_t)(pk & 0xffffu);
        sK[tl * GS + d] = (bf16_t)(pk >> 16);
      }
      {
        const bf16_t* gs = p.gstate + ((size_t)bh * NCH + j) * 8192;
#pragma unroll
        for (int i = 0; i < 4; i++) {
          int id = tid + 256 * i, dv = id >> 3, d8 = id & 7;
          *(u32x4*)(sSt + dv * GS + d8 * 8) = *(const u32x4*)(gs + dv * 64 + d8 * 8);
        }
      }
      __syncthreads();
      {
        const int tqT = w & 1, tsT = w >> 1;
        f32x16 pa;
#pragma unroll
        for (int e = 0; e < 16; e++) pa[e] = 0.f;
        if (tsT <= tqT) {
#pragma unroll
          for (int ks = 0; ks < 4; ks++) {
            const bfx8 ak = *(const bfx8*)(sK + (tsT * 32 + r) * GS + ks * 16 + hh * 8);
            const bfx8 bq = *(const bfx8*)(sQ + (tqT * 32 + r) * GS + ks * 16 + hh * 8);
            pa = __builtin_amdgcn_mfma_f32_32x32x16_bf16(ak, bq, pa, 0, 0, 0);
          }
        }
        const int tq = tqT * 32 + r;
#pragma unroll
        for (int q = 0; q < 4; q++) {
          int ts = tsT * 32 + 8 * q + 4 * hh;
          float v0 = (ts + 0 <= tq) ? pa[4 * q + 0] : 0.f, v1 = (ts + 1 <= tq) ? pa[4 * q + 1] : 0.f;
          float v2 = (ts + 2 <= tq) ? pa[4 * q + 2] : 0.f, v3 = (ts + 3 <= tq) ? pa[4 * q + 3] : 0.f;
          u32x2 o = {pack2(v0, v1), pack2(v2, v3)};
          *(u32x2*)(sP + tq * GS + ts) = o;
        }
      }
      __syncthreads();
      {
        const int tqT = w & 1, dvT = (w >> 1) * 2;
        f32x16 o0, o1;
#pragma unroll
        for (int e = 0; e < 16; e++) { o0[e] = 0.f; o1[e] = 0.f; }
#pragma unroll
        for (int ks = 0; ks < 4; ks++) {
          const bfx8 bp = *(const bfx8*)(sP + (tqT * 32 + r) * GS + ks * 16 + hh * 8);
          const bfx8 v0 = *(const bfx8*)(sVt + (dvT * 32 + r) * GS + ks * 16 + hh * 8);
          const bfx8 v1 = *(const bfx8*)(sVt + (dvT * 32 + 32 + r) * GS + ks * 16 + hh * 8);
          o0 = __builtin_amdgcn_mfma_f32_32x32x16_bf16(v0, bp, o0, 0, 0, 0);
          o1 = __builtin_amdgcn_mfma_f32_32x32x16_bf16(v1, bp, o1, 0, 0, 0);
        }
#pragma unroll
        for (int ks = 0; ks < 4; ks++) {
          const bfx8 bq = *(const bfx8*)(sQ + (tqT * 32 + r) * GS + ks * 16 + hh * 8);
          const bfx8 s0 = *(const bfx8*)(sSt + (dvT * 32 + r) * GS + ks * 16 + hh * 8);
          const bfx8 s1 = *(const bfx8*)(sSt + (dvT * 32 + 32 + r) * GS + ks * 16 + hh * 8);
          o0 = __builtin_amdgcn_mfma_f32_32x32x16_bf16(s0, bq, o0, 0, 0, 0);
          o1 = __builtin_amdgcn_mfma_f32_32x32x16_bf16(s1, bq, o1, 0, 0, 0);
        }
        float ssq = 0.f;
#pragma unroll
        for (int e = 0; e < 16; e++) ssq += o0[e] * o0[e] + o1[e] * o1[e];
        ssq += __shfl_xor(ssq, 32);
        const int tq = tqT * 32 + r;
        if (hh == 0) sRed[(w >> 1) * 64 + tq] = ssq;
        __syncthreads();
        const float tot = sRed[tq] + sRed[64 + tq];
        const float rs = rsqrtf(tot * (1.f / 128.f) + 1e-6f);
        bf16_t* sO = sSt;
        const int prow = tid >> 4, pc = tid & 15;
        bf16_t* ob = p.proj + (size_t)(b * LSEQ + t0 + prow) * DIN + h * 128 + pc * 8;
        u32x4 ggv[4];
#pragma unroll
        for (int i = 0; i < 4; i++) ggv[i] = *(const u32x4*)(ob + (size_t)(16 * i) * DIN + C_GG);
        const f32x4 gna = *(const f32x4*)(p.gla_g + layer * 512 + h * 128 + pc * 8);
        const f32x4 gnb = *(const f32x4*)(p.gla_g + layer * 512 + h * 128 + pc * 8 + 4);
#pragma unroll
        for (int q = 0; q < 4; q++) {
          u32x2 w0 = {pack2(o0[4 * q + 0] * rs, o0[4 * q + 1] * rs), pack2(o0[4 * q + 2] * rs, o0[4 * q + 3] * rs)};
          u32x2 w1 = {pack2(o1[4 * q + 0] * rs, o1[4 * q + 1] * rs), pack2(o1[4 * q + 2] * rs, o1[4 * q + 3] * rs)};
          *(u32x2*)(sO + tq * 136 + dvT * 32 + 8 * q + 4 * hh) = w0;
          *(u32x2*)(sO + tq * 136 + (dvT + 1) * 32 + 8 * q + 4 * hh) = w1;
        }
        __syncthreads();
#pragma unroll
        for (int i = 0; i < 4; i++) {
          const int row = prow + 16 * i;
          const u32x4 ov = *(const u32x4*)(sO + row * 136 + pc * 8);
          u32x4 o;
#pragma unroll
          for (int k = 0; k < 4; k++) {
            const float ga_ = (k < 2) ? gna[2 * k] : gnb[2 * k - 4], gb_ = (k < 2) ? gna[2 * k + 1] : gnb[2 * k - 3];
            float ya = __uint_as_float(ov[k] << 16) * ga_ * siluf_(__uint_as_float(ggv[i][k] << 16));
            float yb = __uint_as_float(ov[k] & 0xffff0000u) * gb_ * siluf_(__uint_as_float(ggv[i][k] & 0xffff0000u));
            o[k] = pack2(ya, yb);
          }
          if (t0 + row < TV0) { o[0] = 0u; o[1] = 0u; o[2] = 0u; o[3] = 0u; }
          *(u32x4*)(ob + (size_t)(16 * i) * DIN + C_YG) = o;
        }
      }
    }
  }
}

__device__ __forceinline__ void ph_gla_scan(const Prm& p, int gtid, int gthreads) {
  for (int i = gtid; i < 16 * 4096; i += gthreads) {
    const int bh = i >> 12, e = (i & 4095) * 2, dd = e & 63;
    unsigned* gs = (unsigned*)(p.gstate + (size_t)bh * NCH * 8192 + e);
    const float* gd = p.gdec + (size_t)bh * NCH * 64 + dd;
    float S0 = 0.f, S1 = 0.f;
    for (int j0 = 0; j0 < NCH; j0 += 13) {
      unsigned G[13]; float Da[13], Db[13];
#pragma unroll
      for (int k = 0; k < 13; k++) { G[k] = gs[(size_t)(j0 + k) * 4096]; Da[k] = gd[(j0 + k) * 64]; Db[k] = gd[(j0 + k) * 64 + 1]; }
#pragma unroll
      for (int k = 0; k < 13; k++) {
        gs[(size_t)(j0 + k) * 4096] = pack2(S0, S1);
        S0 = Da[k] * S0 + __uint_as_float(G[k] << 16);
        S1 = Db[k] * S1 + __uint_as_float(G[k] & 0xffff0000u);
      }
    }
  }
}


__device__ __forceinline__ void ph_foxsum(const Prm& p, int layer) {
  const int lane = threadIdx.x & 63;
  const int wave = (blockIdx.x * blockDim.x + threadIdx.x) >> 6;
  const int nw = (gridDim.x * blockDim.x) >> 6;
  for (int it = wave; it < 32 * NCH; it += nw) {
    const int bh = it / NCH, j = it % NCH, b = bh >> 3, h = bh & 7;
    const int t = j * 64 + lane;
    float lf = 0.f;
    if (t >= TV0) lf = logsigf_(bf2f(p.proj[(size_t)(b * LSEQ + t) * DIN + C_FF + h]) + p.b_f[layer * 8 + h]);
    lf = wave_sum(lf);
    float sq = 0.f, sk = 0.f;
    {
      const u32x4* qp = (const u32x4*)(p.proj + (size_t)(b * LSEQ + t) * DIN + C_FQ + h * 64);
      const u32x4* kp = (const u32x4*)(p.proj + (size_t)(b * LSEQ + t) * DIN + C_FK + h * 64);
#pragma unroll
      for (int i = 0; i < 8; i++) {
        const u32x4 a = qp[i], c = kp[i];
#pragma unroll
        for (int k = 0; k < 4; k++) {
          float x0 = __uint_as_float(a[k] << 16), x1 = __uint_as_float(a[k] & 0xffff0000u);
          float y0 = __uint_as_float(c[k] << 16), y1 = __uint_as_float(c[k] & 0xffff0000u);
          sq += x0 * x0 + x1 * x1; sk += y0 * y0 + y1 * y1;
        }
      }
    }
    sq = wave_max(sq); sk = wave_max(sk);
    if (lane == 0) { p.fsum[it] = lf; p.fnorm[it * 2] = sq; p.fnorm[it * 2 + 1] = sk; }
  }
}
__device__ __forceinline__ void ph_foxc(const Prm& p, int layer) {
  const int lane = threadIdx.x & 63;
  const int wave = (blockIdx.x * blockDim.x + threadIdx.x) >> 6;
  const int nw = (gridDim.x * blockDim.x) >> 6;
  for (int it = wave; it < 32 * NCH; it += nw) {
    const int bh = it / NCH, j = it % NCH, b = bh >> 3, h = bh & 7;
    const float* fs = p.fsum + bh * NCH;
    float base = 0.f;
    if (lane < j) base += fs[lane];
    if (lane + 64 < j) base += fs[lane + 64];
    if (lane + 128 < j) base += fs[lane + 128];
    base = wave_sum(base);
    const int t = j * 64 + lane;
    float lf = 0.f;
    if (t >= TV0) lf = logsigf_(bf2f(p.proj[(size_t)(b * LSEQ + t) * DIN + C_FF + h]) + p.b_f[layer * 8 + h]);
#pragma unroll
    for (int off = 1; off < 64; off <<= 1) {
      float y = __shfl_up(lf, off);
      if (lane >= off) lf += y;
    }
    p.cfox[(size_t)bh * LSEQ + t] = base + lf;
  }
}

#define FS 72
#define LOG2E 1.4426950408889634f
__device__ __forceinline__ void ph_fox(const Prm& p, char* smem, const int item) {
  bf16_t* sK = (bf16_t*)smem;
  bf16_t* sVt = sK + 64 * FS;
  float* sC = (float*)(sVt + 64 * FS);
  int tid = threadIdx.x; asm volatile("" : "+v"(tid));
  const int lane = tid & 63, w = __builtin_amdgcn_readfirstlane(tid >> 6), r = lane & 31, hh = lane >> 5;
  {
    const int qb = 64 - item / 32, bh = item % 32, b = bh >> 3, h = bh & 7;
    const int q0 = qb * 128 + w * 32, tq = q0 + r;
    const bf16_t* pbase = p.proj + (size_t)b * LSEQ * DIN;
    const float* cr = p.cfox + (size_t)bh * LSEQ;
    bfx8 qf0, qf1, qf2, qf3;
    {
      const bf16_t* qp = pbase + (size_t)tq * DIN + C_FQ + h * 64 + hh * 8;
      qf0 = *(const bfx8*)(qp); qf1 = *(const bfx8*)(qp + 16); qf2 = *(const bfx8*)(qp + 32); qf3 = *(const bfx8*)(qp + 48);
    }
    float m = -1e30f, l = 0.f;
    f32x16 o0, o1;
#pragma unroll
    for (int e = 0; e < 16; e++) { o0[e] = 0.f; o1[e] = 0.f; }
    const int ktlast = 2 * qb + 1;
    int ktfirst, ktwave;
    {
      const float* fn = p.fnorm + (size_t)bh * NCH * 2;
      float kk = 0.f;
#pragma unroll
      for (int i = 0; i < 3; i++) { const int idx = lane + 64 * i; if (idx < NCH) kk = fmaxf(kk, fn[idx * 2 + 1]); }
      kk = wave_max(kk);
      const float qq = fmaxf(fn[(qb * 2) * 2], fn[(qb * 2 + 1) * 2]);
      const float bound = 0.3607f * sqrtf(qq * kk) + 160.f;
      const float ct = cr[qb * 128] * LOG2E;
      int first = ktlast;
#pragma unroll
      for (int i = 2; i >= 0; i--) {
        const int kt = 1 + lane + 64 * i;
        bool keep = false;
        if (kt <= ktlast) keep = (ct - cr[kt * 64 + 63] * LOG2E + bound) >= 0.f;
        const unsigned long long bm = __ballot(keep);
        if (bm) first = 1 + 64 * i + (int)__builtin_ctzll(bm);
      }
      ktfirst = __builtin_amdgcn_readfirstlane(first);
      const float boundw = 0.3607f * sqrtf(fn[(q0 >> 6) * 2] * kk) + 160.f;
      const float ctw = cr[q0] * LOG2E;
      int firstw = ktlast;
#pragma unroll
      for (int i = 2; i >= 0; i--) {
        const int kt = 1 + lane + 64 * i;
        bool keep = false;
        if (kt <= ktlast) keep = (ctw - cr[kt * 64 + 63] * LOG2E + boundw) >= 0.f;
        const unsigned long long bm = __ballot(keep);
        if (bm) firstw = 1 + 64 * i + (int)__builtin_ctzll(bm);
      }
      ktwave = __builtin_amdgcn_readfirstlane(firstw);
    }
    const int krow = tid >> 3, kch = tid & 7;
    const int vkey = tid & 63, vc8 = tid >> 6;
    u32x4 rk0, rk1, rv0, rv1; float rc = 0.f;
    {
      const int k0 = ktfirst * 64;
      rk0 = *(const u32x4*)(pbase + (size_t)(k0 + krow) * DIN + C_FK + h * 64 + kch * 8);
      rk1 = *(const u32x4*)(pbase + (size_t)(k0 + krow + 32) * DIN + C_FK + h * 64 + kch * 8);
      rv0 = *(const u32x4*)(pbase + (size_t)(k0 + vkey) * DIN + C_FV + h * 64 + vc8 * 8);
      rv1 = *(const u32x4*)(pbase + (size_t)(k0 + vkey) * DIN + C_FV + h * 64 + (vc8 + 4) * 8);
      if (tid < 64) rc = cr[k0 + tid];
    }
#pragma unroll 1
    for (int kt = ktfirst; kt <= ktlast; kt++) {
      const int k0 = kt * 64;
      __syncthreads();
      *(u32x4*)(sK + krow * FS + kch * 8) = rk0;
      *(u32x4*)(sK + (krow + 32) * FS + kch * 8) = rk1;
#pragma unroll
      for (int q = 0; q < 4; q++) {
        sVt[(vc8 * 8 + 2 * q) * FS + vkey] = (bf16_t)(rv0[q] & 0xffffu);
        sVt[(vc8 * 8 + 2 * q + 1) * FS + vkey] = (bf16_t)(rv0[q] >> 16);
        sVt[((vc8 + 4) * 8 + 2 * q) * FS + vkey] = (bf16_t)(rv1[q] & 0xffffu);
        sVt[((vc8 + 4) * 8 + 2 * q + 1) * FS + vkey] = (bf16_t)(rv1[q] >> 16);
      }
      if (tid < 64) sC[tid] = -rc * LOG2E;
      __syncthreads();
      if (kt < ktlast) {
        const int k1 = k0 + 64;
        rk0 = *(const u32x4*)(pbase + (size_t)(k1 + krow) * DIN + C_FK + h * 64 + kch * 8);
        rk1 = *(const u32x4*)(pbase + (size_t)(k1 + krow + 32) * DIN + C_FK + h * 64 + kch * 8);
        rv0 = *(const u32x4*)(pbase + (size_t)(k1 + vkey) * DIN + C_FV + h * 64 + vc8 * 8);
        rv1 = *(const u32x4*)(pbase + (size_t)(k1 + vkey) * DIN + C_FV + h * 64 + (vc8 + 4) * 8);
        if (tid < 64) rc = cr[k1 + tid];
      }
      if (k0 <= q0 + 31 && kt >= ktwave) {
        f32x16 s0, s1;
#pragma unroll
        for (int e = 0; e < 16; e++) { s0[e] = 0.f; s1[e] = 0.f; }
        {
          const bf16_t* ka = sK + r * FS + hh * 8;
          const bf16_t* kb = sK + (32 + r) * FS + hh * 8;
          s0 = __builtin_amdgcn_mfma_f32_32x32x16_bf16(*(const bfx8*)(ka), qf0, s0, 0, 0, 0);
          s1 = __builtin_amdgcn_mfma_f32_32x32x16_bf16(*(const bfx8*)(kb), qf0, s1, 0, 0, 0);
          s0 = __builtin_amdgcn_mfma_f32_32x32x16_bf16(*(const bfx8*)(ka + 16), qf1, s0, 0, 0, 0);
          s1 = __builtin_amdgcn_mfma_f32_32x32x16_bf16(*(const bfx8*)(kb + 16), qf1, s1, 0, 0, 0);
          s0 = __builtin_amdgcn_mfma_f32_32x32x16_bf16(*(const bfx8*)(ka + 32), qf2, s0, 0, 0, 0);
          s1 = __builtin_amdgcn_mfma_f32_32x32x16_bf16(*(const bfx8*)(kb + 32), qf2, s1, 0, 0, 0);
          s0 = __builtin_amdgcn_mfma_f32_32x32x16_bf16(*(const bfx8*)(ka + 48), qf3, s0, 0, 0, 0);
          s1 = __builtin_amdgcn_mfma_f32_32x32x16_bf16(*(const bfx8*)(kb + 48), qf3, s1, 0, 0, 0);
        }
        const bool need_mask = (kt == 1) || (k0 + 63 > q0);
        float mx = -1e30f;
        if (need_mask) {
#pragma unroll
          for (int q = 0; q < 4; q++) {
            const f32x4 c0 = *(const f32x4*)(sC + 8 * q + 4 * hh);
            const f32x4 c1 = *(const f32x4*)(sC + 32 + 8 * q + 4 * hh);
#pragma unroll
            for (int i = 0; i < 4; i++) {
              float a = fmaf(s0[4 * q + i], 0.125f * LOG2E, c0[i]);
              float bb = fmaf(s1[4 * q + i], 0.125f * LOG2E, c1[i]);
              const int key0 = k0 + 8 * q + 4 * hh + i, key1 = key0 + 32;
              a = (key0 > tq || key0 < TV0) ? -1e30f : a;
              bb = (key1 > tq || key1 < TV0) ? -1e30f : bb;
              s0[4 * q + i] = a; s1[4 * q + i] = bb;
              mx = fmaxf(mx, fmaxf(a, bb));
            }
          }
        } else {
#pragma unroll
          for (int q = 0; q < 4; q++) {
            const f32x4 c0 = *(const f32x4*)(sC + 8 * q + 4 * hh);
            const f32x4 c1 = *(const f32x4*)(sC + 32 + 8 * q + 4 * hh);
#pragma unroll
            for (int i = 0; i < 4; i++) {
              float a = fmaf(s0[4 * q + i], 0.125f * LOG2E, c0[i]);
              float bb = fmaf(s1[4 * q + i], 0.125f * LOG2E, c1[i]);
              s0[4 * q + i] = a; s1[4 * q + i] = bb;
              mx = fmaxf(mx, fmaxf(a, bb));
            }
          }
        }
        mx = fmaxf(mx, __shfl_xor(mx, 32));
        const float mn = fmaxf(m, mx);
        const float alpha = __builtin_amdgcn_exp2f(m - mn);
        m = mn;
        float ls = 0.f;
#pragma unroll
        for (int e = 0; e < 16; e++) {
          s0[e] = __builtin_amdgcn_exp2f(s0[e] - mn);
          s1[e] = __builtin_amdgcn_exp2f(s1[e] - mn);
          ls += s0[e] + s1[e];
          o0[e] *= alpha; o1[e] *= alpha;
        }
        l = l * alpha + ls;
        union { bfx8 v; unsigned u[4]; } pf;
#pragma unroll
        for (int st = 0; st < 4; st++) {
          const int i = st >> 1, sp = st & 1;
#pragma unroll
          for (int q = 0; q < 4; q++) {
            float x0 = i ? s1[8 * sp + 2 * q] : s0[8 * sp + 2 * q];
            float x1 = i ? s1[8 * sp + 2 * q + 1] : s0[8 * sp + 2 * q + 1];
            pf.u[q] = pack2(x0, x1);
          }
          const int kofs = i * 32 + 16 * sp + 4 * hh;
          union { bfx8 v; u32x2 h2[2]; } va, vb;
          va.h2[0] = *(const u32x2*)(sVt + r * FS + kofs);
          va.h2[1] = *(const u32x2*)(sVt + r * FS + kofs + 8);
          vb.h2[0] = *(const u32x2*)(sVt + (32 + r) * FS + kofs);
          vb.h2[1] = *(const u32x2*)(sVt + (32 + r) * FS + kofs + 8);
          o0 = __builtin_amdgcn_mfma_f32_32x32x16_bf16(va.v, pf.v, o0, 0, 0, 0);
          o1 = __builtin_amdgcn_mfma_f32_32x32x16_bf16(vb.v, pf.v, o1, 0, 0, 0);
        }
      }
    }
    l += __shfl_xor(l, 32);
    const float inv = __builtin_amdgcn_rcpf(l);
    bf16_t* row = p.proj + (size_t)(b * LSEQ + tq) * DIN;
    const bool valid = tq >= TV0;
#pragma unroll
    for (int q = 0; q < 4; q++) {
#pragma unroll
      for (int i = 0; i < 2; i++) {
        const int dh = i * 32 + 8 * q + 4 * hh;
        u32x2 gg = *(const u32x2*)(row + C_FG + h * 64 + dh);
        float g0 = __uint_as_float(gg[0] << 16), g1 = __uint_as_float(gg[0] & 0xffff0000u);
        float g2 = __uint_as_float(gg[1] << 16), g3 = __uint_as_float(gg[1] & 0xffff0000u);
        float y0 = (i ? o1[4 * q + 0] : o0[4 * q + 0]) * inv * siluf_(g0);
        float y1 = (i ? o1[4 * q + 1] : o0[4 * q + 1]) * inv * siluf_(g1);
        float y2 = (i ? o1[4 * q + 2] : o0[4 * q + 2]) * inv * siluf_(g2);
        float y3 = (i ? o1[4 * q + 3] : o0[4 * q + 3]) * inv * siluf_(g3);
        u32x2 o = {pack2(y0, y1), pack2(y2, y3)};
        if (!valid) { o[0] = 0u; o[1] = 0u; }
        *(u32x2*)(row + C_YF + h * 64 + dh) = o;
      }
    }
  }
}


__device__ __forceinline__ void gbar(unsigned* bar, unsigned& epoch) {
  epoch++;
  __syncthreads();
  if (threadIdx.x == 0) {
    __builtin_amdgcn_fence(__ATOMIC_RELEASE, "agent");
    const unsigned g = blockIdx.x & 15u;
    const unsigned gsz = (gridDim.x - g + 15u) >> 4;
    const unsigned old = atomicAdd(&bar[32 + 32 * g], 1u);
    if (old + 1u == epoch * gsz) {
      const unsigned o2 = atomicAdd(&bar[0], 1u);
      if (o2 + 1u == epoch * 16u) __hip_atomic_store(&bar[16], epoch, __ATOMIC_RELEASE, __HIP_MEMORY_SCOPE_AGENT);
    }
    while (__hip_atomic_load(&bar[16], __ATOMIC_RELAXED, __HIP_MEMORY_SCOPE_AGENT) < epoch) __builtin_amdgcn_s_sleep(1);
    __builtin_amdgcn_fence(__ATOMIC_ACQUIRE, "agent");
  }
  __syncthreads();
}

#define N_PHASES 15
template <int S>
__device__ __forceinline__ void run_stage(const Prm& p, int layer, float* smem) {
  if (S == 0) ph_gemm_glds<4, false>(p.r1, DM, p.wt_in + (size_t)layer * DIN * DM, DIN, DM, p.proj, DIN, (char*)smem);
  if (S == 1) ph_foxscan(p, layer);
  if (S == 3) ph_gla_naive(p, layer, smem);
  if (S == 4) ph_lru_naive_b(p, layer, smem, blockIdx.x);
  if (S == 5) ph_gemm_out(p.proj, p.wt_out + (size_t)layer * DM * DMIX, p.r1, (char*)smem);
  if (S == 6) ph_post(p, layer);
  if (S == 7) {
    ph_prenorm0(p);
    for (int l = 0; l < 2; l++) {
      ph_wtrans(p.w_in + (size_t)l * DM * DIN, DM, DIN, p.wt_in + (size_t)l * DIN * DM, smem, blockIdx.x, gridDim.x, 1, 32);
      ph_wtrans(p.w_out + (size_t)l * DMIX * DM, DMIX, DM, p.wt_out + (size_t)l * DM * DMIX, smem, blockIdx.x, gridDim.x, 1, 64);
    }
    ph_wtrans(p.w_r, 128, 128, p.wt_r, smem, blockIdx.x, gridDim.x, 16);
    ph_wtrans(p.w_i, 128, 128, p.wt_i, smem, blockIdx.x, gridDim.x, 16);
  }
}

template <int S>
__global__ void __launch_bounds__(256) k_stage(Prm p, int layer) {
  __shared__ __attribute__((aligned(16))) float smem[SMEM_BYTES / 4];
  run_stage<S>(p, layer, smem);
}

__global__ void __launch_bounds__(256, 2) k_mega(Prm p) {
  __shared__ __attribute__((aligned(16))) float smem[SMEM_BYTES / 4];
  __shared__ int sIdx;
  cg::grid_group grid = cg::this_grid();
  unsigned epoch = 0;
  if (blockIdx.x == 0) { for (int i = threadIdx.x; i < 1024; i += blockDim.x) p.bar[i] = 0u; }
  run_stage<7>(p, 0, smem);
  grid.sync();
  for (int layer = 0; layer < 2; layer++) {
    run_stage<0>(p, layer, smem); gbar(p.bar, epoch);
#if PROBE_G
    run_stage<0>(p, layer, smem); gbar(p.bar, epoch);
#endif
    ph_foxsum(p, layer);
#pragma unroll 1
    for (;;) {
      __syncthreads();
      if (threadIdx.x == 0) sIdx = (int)atomicAdd(&p.bar[640 + layer * 64], 1u);
      __syncthreads();
      const int idx = sIdx;
      if (idx >= 16 * NCH + NB * NCH * 8) break;
      if (idx < 16 * NCH) ph_gla<false>(p, layer, (char*)smem, idx);
      else ph_lru<false>(p, layer, (char*)smem, idx - 16 * NCH);
    }
    gbar(p.bar, epoch);
    ph_foxc(p, layer);
    ph_gla_scan(p, blockIdx.x * blockDim.x + threadIdx.x, gridDim.x * blockDim.x);
    ph_lru_scan(p, blockIdx.x * blockDim.x + threadIdx.x, gridDim.x * blockDim.x);
    gbar(p.bar, epoch);
#pragma unroll 1
    for (;;) {
      __syncthreads();
      if (threadIdx.x == 0) sIdx = (int)atomicAdd(&p.bar[640 + layer * 64 + 32], 1u);
      __syncthreads();
      const int idx = sIdx;
      if (idx >= 32 * 65 + 16 * NCH + NB * NCH * 8) break;
      if (idx < 32 * 65) ph_fox(p, (char*)smem, idx);
      else if (idx < 32 * 65 + 16 * NCH) ph_gla<true>(p, layer, (char*)smem, idx - 32 * 65);
      else ph_lru<true>(p, layer, (char*)smem, idx - 32 * 65 - 16 * NCH);
    }
    gbar(p.bar, epoch);
    run_stage<5>(p, layer, smem); gbar(p.bar, epoch);
#if PROBE_G
    run_stage<5>(p, layer, smem); gbar(p.bar, epoch);
#endif
    run_stage<6>(p, layer, smem);
    if (layer == 0) gbar(p.bar, epoch);
  }
}


extern "C" void kernel_launch(void* const* d_in, const int* in_sizes, int n_in, void* d_out, int out_size,
                              void* d_ws, size_t ws_size, hipStream_t stream) {
  Prm p{};
  p.x = (const float*)d_in[0]; p.meta = (const float*)d_in[1]; p.pre_g = (const float*)d_in[2];
  p.w_in = (const float*)d_in[3]; p.b_f = (const float*)d_in[4]; p.w_a2 = (const float*)d_in[5];
  p.b_a = (const float*)d_in[6]; p.gla_g = (const float*)d_in[7]; p.conv_w = (const float*)d_in[8];
  p.conv_b = (const float*)d_in[9]; p.w_r = (const float*)d_in[10]; p.b_r = (const float*)d_in[11];
  p.w_i = (const float*)d_in[12]; p.b_i = (const float*)d_in[13]; p.lam = (const float*)d_in[14];
  p.w_out = (const float*)d_in[15]; p.post_g = (const float*)d_in[16];
  p.out = (float*)d_out;
  char* ws = (char*)d_ws;
  size_t off = 0;
  p.proj = (bf16_t*)(ws + off); off += (size_t)NTOK * DIN * 2;
  p.r1 = (bf16_t*)(ws + off); off += (size_t)NTOK * DM * 2;
  p.cfox = (float*)(ws + off); off += (size_t)NB * 8 * LSEQ * 4;
  p.hmeta = (float*)(ws + off); off += (size_t)NB * 16 * DM * 4;
  p.wt_in = (bf16_t*)(ws + off); off += (size_t)2 * DIN * DM * 2;
  p.wt_out = (bf16_t*)(ws + off); off += (size_t)2 * DM * DMIX * 2;
  p.wt_r = (bf16_t*)(ws + off); off += (size_t)2 * 8 * 128 * 128 * 2;
  p.wt_i = (bf16_t*)(ws + off); off += (size_t)2 * 8 * 128 * 128 * 2;
  p.lruP = (float*)(ws + off); off += (size_t)NB * 130 * 1024 * 4;
  p.lruH = (float*)(ws + off); off += (size_t)NB * 130 * 1024 * 4;
  p.gstate = (bf16_t*)p.r1;
  p.gdec = (float*)(ws + off); off += (size_t)16 * 130 * 64 * 4;
  p.bar = (unsigned*)(ws + off); off += 4096;
  p.fsum = (float*)(ws + off); off += 32 * 130 * 4 + 128;
  p.fnorm = (float*)(ws + off); off += 32 * 130 * 2 * 4 + 128;
  p.gB = (float*)(ws + off); off += (size_t)16 * 130 * 64 * 64 * 4;
#if MEGA
  static int grid_blocks = 0;
  if (!grid_blocks) {
    int dev = 0, cus = 0, per_cu = 0;
    hipGetDevice(&dev);
    hipDeviceGetAttribute(&cus, hipDeviceAttributeMultiprocessorCount, dev);
    hipOccupancyMaxActiveBlocksPerMultiprocessor(&per_cu, k_mega, 256, 0);
    if (per_cu > 4) per_cu = 4;
    grid_blocks = cus * per_cu;
  }
  void* args[] = {&p};
  hipError_t e = hipLaunchCooperativeKernel((void*)k_mega, dim3(grid_blocks), dim3(256), args, 0, stream);
  if (e != hipSuccess) fprintf(stderr, "cooperative launch failed: %s (grid %d)\n", hipGetErrorString(e), grid_blocks);
#else
  k_stage<7><<<1024, 256, 0, stream>>>(p, 0);
  for (int layer = 0; layer < 2; layer++) {
    k_stage<0><<<2048, 256, 0, stream>>>(p, layer);
    k_stage<1><<<8, 256, 0, stream>>>(p, layer);
    k_stage<2><<<NB * 8 * 33, 256, 0, stream>>>(p, layer);
    k_stage<3><<<16, 256, 0, stream>>>(p, layer);
    k_stage<4><<<32, 256, 0, stream>>>(p, layer);
    k_stage<5><<<2048, 256, 0, stream>>>(p, layer);
    k_stage<6><<<1024, 256, 0, stream>>>(p, layer);
  }
#endif
}
```

```cpp
#include <hip/hip_runtime.h>
#include <hip/hip_cooperative_groups.h>
#include <cstdio>
namespace cg = cooperative_groups;

#define PROBE_G 0
#define PROBE_M1 0
#ifndef MEGA
#define MEGA 1
#endif

typedef unsigned short bf16_t;
typedef __attribute__((ext_vector_type(8))) short bfx8;
typedef __attribute__((ext_vector_type(16))) float f32x16;
typedef __attribute__((ext_vector_type(4))) float f32x4;
typedef __attribute__((ext_vector_type(4))) unsigned int u32x4;
typedef __attribute__((ext_vector_type(2))) unsigned int u32x2;
#define SMEM_BYTES 73728

#define NB 4
#define LSEQ 8320
#define SEQ 8192
#define NTOK 33280
#define DM 1024
#define DIN 5656
#define DMIX 2048
#define TV0 112
#define PADR 128

#define C_FQ 0
#define C_FK 512
#define C_FV 1024
#define C_FF 1536
#define C_FG 1544
#define C_GQ 2056
#define C_GK 2312
#define C_GV 2568
#define C_GA 3080
#define C_GG 3096
#define C_LX 3608
#define C_LG 4632
#define C_YF C_FQ
#define C_YG C_GV
#define C_YL C_LG

struct Prm {
  const float *x, *meta, *pre_g, *w_in, *b_f, *w_a2, *b_a, *gla_g, *conv_w, *conv_b;
  const float *w_r, *b_r, *w_i, *b_i, *lam, *w_out, *post_g;
  float* out;
  bf16_t* proj;
  bf16_t* r1;
  float* cfox;
  float* hmeta;
  bf16_t* wt_in;
  bf16_t* wt_out;
  bf16_t* wt_r;
  bf16_t* wt_i;
  float* lruP;
  float* lruH;
  bf16_t* gstate;
  float* gdec;
  unsigned* bar;
  float* fsum;
  float* gB;
  float* fnorm;
};

__device__ __forceinline__ float bf2f(bf16_t x) { return __uint_as_float(((unsigned)x) << 16); }
__device__ __forceinline__ bf16_t f2bf(float f) {
  unsigned u = __float_as_uint(f);
  u += 0x7fffu + ((u >> 16) & 1u);
  return (bf16_t)(u >> 16);
}
__device__ __forceinline__ unsigned pack2(float a, float b) { unsigned r; asm("v_cvt_pk_bf16_f32 %0, %1, %2" : "=v"(r) : "v"(a), "v"(b)); return r; }
__device__ __forceinline__ float wave_sum(float v) {
#pragma unroll
  for (int m = 32; m >= 1; m >>= 1) v += __shfl_xor(v, m);
  return v;
}
__device__ __forceinline__ float wave_max(float v) {
#pragma unroll
  for (int m = 32; m >= 1; m >>= 1) v = fmaxf(v, __shfl_xor(v, m));
  return v;
}
__device__ __forceinline__ float sigmoidf_(float x) { return __builtin_amdgcn_rcpf(1.f + __builtin_amdgcn_exp2f(-1.4426950408889634f * x)); }
__device__ __forceinline__ float siluf_(float x) { return x * sigmoidf_(x); }
__device__ __forceinline__ float logsigf_(float x) { return fminf(x, 0.f) - 0.6931471805599453f * __builtin_amdgcn_logf(1.f + __builtin_amdgcn_exp2f(-1.4426950408889634f * fabsf(x))); }
__device__ __forceinline__ float fexpf_(float x) { return __builtin_amdgcn_exp2f(1.4426950408889634f * x); }

__device__ __forceinline__ const float* h_src_row(const Prm& p, int layer, int b, int t) {
  if (t < TV0) return nullptr;
  if (layer == 0) return t < PADR ? p.meta + (size_t)(t - TV0) * DM : p.x + ((size_t)b * SEQ + (t - PADR)) * DM;
  return t < PADR ? p.hmeta + ((size_t)b * 16 + (t - TV0)) * DM : p.out + ((size_t)b * SEQ + (t - PADR)) * DM;
}

__device__ __forceinline__ void ph_prenorm0(const Prm& p) {
  const int lane = threadIdx.x & 63;
  const int wave = (blockIdx.x * blockDim.x + threadIdx.x) >> 6;
  const int nw = (gridDim.x * blockDim.x) >> 6;
  for (int row = wave; row < NTOK; row += nw) {
    int b = row / LSEQ, t = row % LSEQ;
    auto dstp = [&](int i) { const int k = (lane + 64 * i) * 4; return (uint2*)(p.r1 + ((size_t)(k >> 5) * NTOK + row) * 32 + (k & 31)); };
    const float* src = h_src_row(p, 0, b, t);
    if (!src) {
#pragma unroll
      for (int i = 0; i < 4; i++) *dstp(i) = make_uint2(0u, 0u);
      continue;
    }
    float4 v[4]; float ss = 0.f;
#pragma unroll
    for (int i = 0; i < 4; i++) {
      v[i] = ((const float4*)src)[lane + 64 * i];
      ss += v[i].x * v[i].x + v[i].y * v[i].y + v[i].z * v[i].z + v[i].w * v[i].w;
    }
    ss = wave_sum(ss);
    float rs = rsqrtf(ss * (1.f / DM) + 1e-6f);
#pragma unroll
    for (int i = 0; i < 4; i++) {
      float4 g = ((const float4*)p.pre_g)[lane + 64 * i];
      *dstp(i) = make_uint2(pack2(v[i].x * rs * g.x, v[i].y * rs * g.y), pack2(v[i].z * rs * g.z, v[i].w * rs * g.w));
    }
  }
}

__device__ __forceinline__ void ph_post(const Prm& p, int layer) {
  const int lane = threadIdx.x & 63;
  const int wave = (blockIdx.x * blockDim.x + threadIdx.x) >> 6;
  const int nw = (gridDim.x * blockDim.x) >> 6;
  const float* pg = p.post_g + layer * DM;
  for (int row = wave; row < NTOK; row += nw) {
    int b = row / LSEQ, t = row % LSEQ;
    auto zrp = [&](int i) { const int k = (lane + 64 * i) * 4; return (uint2*)(p.r1 + ((size_t)(k >> 5) * NTOK + row) * 32 + (k & 31)); };
    if (t < TV0) {
      if (layer == 0) {
#pragma unroll
        for (int i = 0; i < 4; i++) *zrp(i) = make_uint2(0u, 0u);
      }
      continue;
    }
    float4 z[4]; float ss = 0.f;
#pragma unroll
    for (int i = 0; i < 4; i++) {
      uint2 u = *zrp(i);
      z[i].x = __uint_as_float(u.x << 16); z[i].y = __uint_as_float(u.x & 0xffff0000u);
      z[i].z = __uint_as_float(u.y << 16); z[i].w = __uint_as_float(u.y & 0xffff0000u);
      ss += z[i].x * z[i].x + z[i].y * z[i].y + z[i].z * z[i].z + z[i].w * z[i].w;
    }
    ss = wave_sum(ss);
    float rs = rsqrtf(ss * (1.f / DM) + 1e-6f);
    const float* hs = h_src_row(p, layer, b, t);
    float ss2 = 0.f;
#pragma unroll
    for (int i = 0; i < 4; i++) {
      float4 g = ((const float4*)pg)[lane + 64 * i];
      float4 h = ((const float4*)hs)[lane + 64 * i];
      z[i].x = h.x + z[i].x * rs * g.x; z[i].y = h.y + z[i].y * rs * g.y;
      z[i].z = h.z + z[i].z * rs * g.z; z[i].w = h.w + z[i].w * rs * g.w;
      ss2 += z[i].x * z[i].x + z[i].y * z[i].y + z[i].z * z[i].z + z[i].w * z[i].w;
    }
    if (layer == 0) {
      float* hd = t < PADR ? p.hmeta + ((size_t)b * 16 + (t - TV0)) * DM : p.out + ((size_t)b * SEQ + (t - PADR)) * DM;
#pragma unroll
      for (int i = 0; i < 4; i++) ((float4*)hd)[lane + 64 * i] = z[i];
      ss2 = wave_sum(ss2);
      float rs2 = rsqrtf(ss2 * (1.f / DM) + 1e-6f);
      const float* g1 = p.pre_g + DM;
#pragma unroll
      for (int i = 0; i < 4; i++) {
        float4 g = ((const float4*)g1)[lane + 64 * i];
        *zrp(i) = make_uint2(pack2(z[i].x * rs2 * g.x, z[i].y * rs2 * g.y), pack2(z[i].z * rs2 * g.z, z[i].w * rs2 * g.w));
      }
    } else if (t >= PADR) {
      float* hd = p.out + ((size_t)b * SEQ + (t - PADR)) * DM;
#pragma unroll
      for (int i = 0; i < 4; i++) ((float4*)hd)[lane + 64 * i] = z[i];
    }
  }
}

__device__ __forceinline__ int ycol(int k) { return k < 512 ? C_YF + k : (k < 1024 ? C_YG + (k - 512) : C_YL + (k - 1024)); }

__device__ __forceinline__ void ph_gemm_naive(const bf16_t* A, int lda, bool remap, const float* W, int N, int K, bf16_t* C, int ldc, float* smem) {
  float (*As)[68] = (float (*)[68])smem;
  float (*Bs)[68] = (float (*)[68])(smem + 16 * 68);
  const int tid = threadIdx.x, tx = tid & 15, ty = tid >> 4;
  const int ntn = (N + 63) / 64, ntm = NTOK / 64;
  for (int tile = blockIdx.x; tile < ntn * ntm; tile += gridDim.x) {
    int m0 = (tile / ntn) * 64, n0 = (tile % ntn) * 64;
    float acc[4][4] = {};
    for (int k0 = 0; k0 < K; k0 += 16) {
      {
        int m = tid >> 2, kk = (tid & 3) * 4;
        int kc = remap ? ycol(k0 + kk) : k0 + kk;
        uint2 u = *(const uint2*)(A + (size_t)(m0 + m) * lda + kc);
        As[kk + 0][m] = __uint_as_float(u.x << 16); As[kk + 1][m] = __uint_as_float(u.x & 0xffff0000u);
        As[kk + 2][m] = __uint_as_float(u.y << 16); As[kk + 3][m] = __uint_as_float(u.y & 0xffff0000u);
        int kr = tid >> 4, nn = (tid & 15) * 4;
        float4 w = make_float4(0, 0, 0, 0);
        if (n0 + nn < N) w = *(const float4*)(W + (size_t)(k0 + kr) * N + n0 + nn);
        *(float4*)&Bs[kr][nn] = w;
      }
      __syncthreads();
#pragma unroll
      for (int k = 0; k < 16; k++) {
        float4 a = *(const float4*)&As[k][ty * 4];
        float4 b = *(const float4*)&Bs[k][tx * 4];
        float av[4] = {a.x, a.y, a.z, a.w}, bv[4] = {b.x, b.y, b.z, b.w};
#pragma unroll
        for (int i = 0; i < 4; i++)
#pragma unroll
          for (int j = 0; j < 4; j++) acc[i][j] += av[i] * bv[j];
      }
      __syncthreads();
    }
    if (n0 + tx * 4 < N) {
#pragma unroll
      for (int i = 0; i < 4; i++) {
        uint2 o = make_uint2(pack2(acc[i][0], acc[i][1]), pack2(acc[i][2], acc[i][3]));
        *(uint2*)(C + (size_t)(m0 + ty * 4 + i) * ldc + n0 + tx * 4) = o;
      }
    }
  }
}


__device__ __forceinline__ void ph_wtrans(const float* __restrict__ src0, int R, int Cc, bf16_t* __restrict__ dst0, float* smem, int bid, int nblk, int nmat = 1, int tiled = 0) {
  float (*tl)[33] = (float (*)[33])smem;
  const int tid = threadIdx.x, tx = tid & 31, ty = tid >> 5;
  const int ntc = (Cc + 31) / 32, ntr = R / 32;
  for (int tile0 = bid; tile0 < ntc * ntr * nmat; tile0 += nblk) {
    int mat = tile0 / (ntc * ntr), tile = tile0 % (ntc * ntr);
    const float* src = src0 + (size_t)mat * R * Cc;
    bf16_t* dst = dst0 + (size_t)mat * R * Cc;
    int r0 = (tile / ntc) * 32, c0 = (tile % ntc) * 32;
    __syncthreads();
#pragma unroll
    for (int i = 0; i < 4; i++) {
      int rr = ty + 8 * i;
      tl[rr][tx] = (c0 + tx < Cc) ? src[(size_t)(r0 + rr) * Cc + c0 + tx] : 0.f;
    }
    __syncthreads();
#pragma unroll
    for (int i = 0; i < 4; i++) {
      int cc = ty + 8 * i;
      if (c0 + cc < Cc) dst[tiled == 32 ? (((size_t)(r0 >> 5) * Cc + c0 + cc) * 32 + tx) : tiled == 64 ? (((size_t)(r0 >> 6) * Cc + c0 + cc) * 64 + (r0 & 63) + tx) : ((size_t)(c0 + cc) * R + r0 + tx)] = f2bf(tl[tx][cc]);
    }
  }
}

#define GLDS 72
template <bool REMAP>
__device__ __forceinline__ void ph_gemm_mfma(const bf16_t* __restrict__ A, int lda, const bf16_t* __restrict__ Wt, int N, int K,
                             bf16_t* __restrict__ C, int ldc, char* smem_raw) {
  bf16_t* sA = (bf16_t*)smem_raw;
  bf16_t* sB = sA + 128 * GLDS;
  int tid = threadIdx.x; asm volatile("" : "+v"(tid));
  const int lane = tid & 63, w = tid >> 6, wm = w & 1, wn = w >> 1;
  const int r = lane & 31, hh = lane >> 5;
  const int ntn = (N + 127) / 128, ntm = NTOK / 128;
  const int nk = K / 64;
  const int lrow = tid >> 3, lch = tid & 7;
#pragma unroll 1
  for (int tile = blockIdx.x; tile < ntm * ntn; tile += gridDim.x) {
    const int m0 = (tile / ntn) * 128, n0 = (tile % ntn) * 128;
    f32x16 acc[2][2];
#pragma unroll
    for (int a = 0; a < 2; a++)
#pragma unroll
      for (int b = 0; b < 2; b++)
#pragma unroll
        for (int e = 0; e < 16; e++) acc[a][b][e] = 0.f;
    u32x4 ra[4], rb[4];
#pragma unroll
    for (int i = 0; i < 4; i++) {
      int row = lrow + 32 * i;
      int kc = REMAP ? ycol(0) : 0;
      ra[i] = *(const u32x4*)(A + (size_t)(m0 + row) * lda + kc + lch * 8);
      int n = min(n0 + row, N - 1);
      rb[i] = *(const u32x4*)(Wt + (size_t)n * K + lch * 8);
    }
#pragma unroll 1
    for (int kt = 0; kt < nk; kt++) {
      __syncthreads();
#pragma unroll
      for (int i = 0; i < 4; i++) {
        int row = lrow + 32 * i;
        *(u32x4*)(sA + row * GLDS + lch * 8) = ra[i];
        *(u32x4*)(sB + row * GLDS + lch * 8) = rb[i];
      }
      __syncthreads();
      if (kt + 1 < nk) {
#pragma unroll
        for (int i = 0; i < 4; i++) {
          int row = lrow + 32 * i;
          int kc = REMAP ? ycol((kt + 1) * 64) : (kt + 1) * 64;
          ra[i] = *(const u32x4*)(A + (size_t)(m0 + row) * lda + kc + lch * 8);
          int n = min(n0 + row, N - 1);
          rb[i] = *(const u32x4*)(Wt + (size_t)n * K + (kt + 1) * 64 + lch * 8);
        }
      }
#pragma unroll
      for (int ks = 0; ks < 4; ks++) {
        const bfx8 a0 = *(const bfx8*)(sA + (wm * 64 + r) * GLDS + ks * 16 + hh * 8);
        const bfx8 a1 = *(const bfx8*)(sA + (wm * 64 + 32 + r) * GLDS + ks * 16 + hh * 8);
        const bfx8 b0 = *(const bfx8*)(sB + (wn * 64 + r) * GLDS + ks * 16 + hh * 8);
        const bfx8 b1 = *(const bfx8*)(sB + (wn * 64 + 32 + r) * GLDS + ks * 16 + hh * 8);
        acc[0][0] = __builtin_amdgcn_mfma_f32_32x32x16_bf16(b0, a0, acc[0][0], 0, 0, 0);
        acc[0][1] = __builtin_amdgcn_mfma_f32_32x32x16_bf16(b0, a1, acc[0][1], 0, 0, 0);
        acc[1][0] = __builtin_amdgcn_mfma_f32_32x32x16_bf16(b1, a0, acc[1][0], 0, 0, 0);
        acc[1][1] = __builtin_amdgcn_mfma_f32_32x32x16_bf16(b1, a1, acc[1][1], 0, 0, 0);
      }
    }
#pragma unroll
    for (int ni = 0; ni < 2; ni++)
#pragma unroll
      for (int mi = 0; mi < 2; mi++) {
        int m = m0 + wm * 64 + mi * 32 + r;
#pragma unroll
        for (int q = 0; q < 4; q++) {
          int n = n0 + wn * 64 + ni * 32 + 8 * q + 4 * hh;
          if (n < N) {
            uint2 o = make_uint2(pack2(acc[ni][mi][4 * q + 0], acc[ni][mi][4 * q + 1]), pack2(acc[ni][mi][4 * q + 2], acc[ni][mi][4 * q + 3]));
            *(uint2*)(C + (size_t)m * ldc + n) = o;
          }
        }
      }
  }
}


__device__ __forceinline__ void ph_gemm_big(const bf16_t* __restrict__ A, int lda, const bf16_t* __restrict__ Wt, int N, int K,
                             bf16_t* __restrict__ C, int ldc, char* smem_raw) {
  bf16_t* sA = (bf16_t*)smem_raw;
  bf16_t* sB = sA + 256 * GLDS;
  int tid = threadIdx.x; asm volatile("" : "+v"(tid));
  const int lane = tid & 63, w = tid >> 6, wm = w & 1, wn = w >> 1;
  const int r = lane & 31, hh = lane >> 5;
  const int ntn = (N + 127) / 128, ntm = NTOK / 256;
  const int nk = K / 64;
  const int lrow = tid >> 3, lch = tid & 7;
#pragma unroll 1
  for (int tile = blockIdx.x; tile < ntm * ntn; tile += gridDim.x) {
    const int m0 = (tile / ntn) * 256, n0 = (tile % ntn) * 128;
    f32x16 acc[2][4];
#pragma unroll
    for (int a = 0; a < 2; a++)
#pragma unroll
      for (int b = 0; b < 4; b++)
#pragma unroll
        for (int e = 0; e < 16; e++) acc[a][b][e] = 0.f;
    u32x4 ra[8], rb[4];
    const bf16_t* ap = A + (size_t)(m0 + lrow) * lda + lch * 8;
    const bf16_t* bp[4];
#pragma unroll
    for (int i = 0; i < 4; i++) bp[i] = Wt + (size_t)min(n0 + lrow + 32 * i, N - 1) * K + lch * 8;
#pragma unroll
    for (int i = 0; i < 8; i++) ra[i] = *(const u32x4*)(ap + (size_t)(32 * i) * lda);
#pragma unroll
    for (int i = 0; i < 4; i++) rb[i] = *(const u32x4*)(bp[i]);
#pragma unroll 1
    for (int kt = 0; kt < nk; kt++) {
      __syncthreads();
#pragma unroll
      for (int i = 0; i < 8; i++) *(u32x4*)(sA + (lrow + 32 * i) * GLDS + lch * 8) = ra[i];
#pragma unroll
      for (int i = 0; i < 4; i++) *(u32x4*)(sB + (lrow + 32 * i) * GLDS + lch * 8) = rb[i];
      __syncthreads();
      if (kt + 1 < nk) {
#pragma unroll
        for (int i = 0; i < 8; i++) ra[i] = *(const u32x4*)(ap + (size_t)(32 * i) * lda + (kt + 1) * 64);
#pragma unroll
        for (int i = 0; i < 4; i++) rb[i] = *(const u32x4*)(bp[i] + (kt + 1) * 64);
      }
#pragma unroll
      for (int ks = 0; ks < 4; ks++) {
        const bf16_t* xa = sA + (wm * 128 + r) * GLDS + ks * 16 + hh * 8;
        const bf16_t* wb = sB + (wn * 64 + r) * GLDS + ks * 16 + hh * 8;
        const bfx8 b0 = *(const bfx8*)(wb);
        const bfx8 b1 = *(const bfx8*)(wb + 32 * GLDS);
        const bfx8 a0 = *(const bfx8*)(xa);
        const bfx8 a1 = *(const bfx8*)(xa + 32 * GLDS);
        const bfx8 a2 = *(const bfx8*)(xa + 64 * GLDS);
        const bfx8 a3 = *(const bfx8*)(xa + 96 * GLDS);
        acc[0][0] = __builtin_amdgcn_mfma_f32_32x32x16_bf16(b0, a0, acc[0][0], 0, 0, 0);
        acc[1][0] = __builtin_amdgcn_mfma_f32_32x32x16_bf16(b1, a0, acc[1][0], 0, 0, 0);
        acc[0][1] = __builtin_amdgcn_mfma_f32_32x32x16_bf16(b0, a1, acc[0][1], 0, 0, 0);
        acc[1][1] = __builtin_amdgcn_mfma_f32_32x32x16_bf16(b1, a1, acc[1][1], 0, 0, 0);
        acc[0][2] = __builtin_amdgcn_mfma_f32_32x32x16_bf16(b0, a2, acc[0][2], 0, 0, 0);
        acc[1][2] = __builtin_amdgcn_mfma_f32_32x32x16_bf16(b1, a2, acc[1][2], 0, 0, 0);
        acc[0][3] = __builtin_amdgcn_mfma_f32_32x32x16_bf16(b0, a3, acc[0][3], 0, 0, 0);
        acc[1][3] = __builtin_amdgcn_mfma_f32_32x32x16_bf16(b1, a3, acc[1][3], 0, 0, 0);
      }
    }
#pragma unroll
    for (int ni = 0; ni < 2; ni++)
#pragma unroll
      for (int mi = 0; mi < 4; mi++) {
        int m = m0 + wm * 128 + mi * 32 + r;
#pragma unroll
        for (int q = 0; q < 4; q++) {
          int n = n0 + wn * 64 + ni * 32 + 8 * q + 4 * hh;
          if (n < N) {
            u32x2 o = {pack2(acc[ni][mi][4 * q + 0], acc[ni][mi][4 * q + 1]), pack2(acc[ni][mi][4 * q + 2], acc[ni][mi][4 * q + 3])};
            *(u32x2*)(C + (size_t)m * ldc + n) = o;
          }
        }
      }
  }
}


template <int MT, bool REMAP>
__device__ __forceinline__ void ph_gemm_glds(const bf16_t* __restrict__ A, int lda, const bf16_t* __restrict__ Wt, int N, int K,
                             bf16_t* __restrict__ C, int ldc, char* smem_raw) {
  constexpr int BM = MT * 64;
  constexpr int A_BYTES = BM * 64, B_BYTES = 128 * 64, STAGE = A_BYTES + B_BYTES;
  constexpr int NA = BM / 64;
  int tid = threadIdx.x; asm volatile("" : "+v"(tid));
  const int lane = tid & 63, w = __builtin_amdgcn_readfirstlane(tid >> 6), wm = w & 1, wn = w >> 1;
  const int r = lane & 31, hh = lane >> 5;
  const int ntn = (N + 127) / 128, ntm = NTOK / BM;
  const int nk = K / 32;
  const int gi = lane >> 2, gpiece = (lane & 3) ^ ((gi >> 2) & 3);
  const unsigned ldsbase = (unsigned)(size_t)smem_raw;
  const unsigned sw_ = (r >> 2) & 3;
  const unsigned ldsA0 = ldsbase + (wm * (MT * 32) + r) * 64 + ((hh ^ sw_) << 4);
  const unsigned ldsA1 = ldsbase + (wm * (MT * 32) + r) * 64 + (((2 + hh) ^ sw_) << 4);
  const unsigned ldsB0 = ldsbase + (wn * 64 + r) * 64 + ((hh ^ sw_) << 4);
  const unsigned ldsB1 = ldsbase + (wn * 64 + r) * 64 + (((2 + hh) ^ sw_) << 4);
  const int xcd = blockIdx.x & 7, cnt = (ntm - xcd + 7) >> 3, full = cnt >> 3, nslot = gridDim.x >> 3;
  int sq = blockIdx.x >> 3;
  int m0 = 0, n0 = 0;
  const bf16_t* ap[NA];
  const bf16_t* bp[2];
  const size_t akstep = (size_t)NTOK * 32, bkstep = (size_t)N * 32;
#define GEMM_TILE_SETUP(q_)                                                                                          \
  {                                                                                                                  \
    int g = (q_) / (8 * ntn), gm = 8, rem = (q_) - g * 8 * ntn;                                                      \
    if (g >= full) { g = full; gm = cnt - 8 * full; rem = (q_) - full * 8 * ntn; }                                   \
    const int nt_ = rem / gm, mi_ = rem - nt_ * gm;                                                                  \
    m0 = ((g * 8 + mi_) * 8 + xcd) * BM; n0 = nt_ * 128;                                                             \
    _Pragma("unroll") for (int i = 0; i < NA; i++)                                                                   \
      ap[i] = REMAP ? A + (size_t)(m0 + (w * NA + i) * 16 + gi) * lda + gpiece * 8                                   \
                    : A + (size_t)(m0 + (w * NA + i) * 16 + gi) * 32 + gpiece * 8;                                   \
    _Pragma("unroll") for (int i = 0; i < 2; i++)                                                                    \
      bp[i] = Wt + (size_t)min(n0 + (w * 2 + i) * 16 + gi, N - 1) * 32 + gpiece * 8;                                 \
    _Pragma("unroll") for (int st = 0; st < 2; st++) {                                                               \
      const size_t kc = REMAP ? (size_t)ycol(st * 32) : (size_t)st * akstep;                                         \
      char* nxt = smem_raw + st * STAGE;                                                                             \
      _Pragma("unroll") for (int i = 0; i < NA; i++)                                                                 \
        __builtin_amdgcn_global_load_lds((const unsigned*)(ap[i] + kc), (unsigned*)(nxt + (w * NA + i) * 1024), 16, 0, 0); \
      _Pragma("unroll") for (int i = 0; i < 2; i++)                                                                  \
        __builtin_amdgcn_global_load_lds((const unsigned*)(bp[i] + st * bkstep), (unsigned*)(nxt + A_BYTES + (w * 2 + i) * 1024), 16, 0, 0); \
    }                                                                                                                \
  }
  __syncthreads();
  if (sq < cnt * ntn) GEMM_TILE_SETUP(sq)
#pragma unroll 1
  while (sq < cnt * ntn) {
    const int cm0 = m0, cn0 = n0;
    f32x16 acc[2][MT];
#pragma unroll
    for (int a = 0; a < 2; a++)
#pragma unroll
      for (int b = 0; b < MT; b++)
#pragma unroll
        for (int e = 0; e < 16; e++) acc[a][b][e] = 0.f;
    int cb = 0;
#pragma unroll 1
    for (int kt = 0; kt < nk; kt++) {
      if (kt + 1 < nk) { if (NA == 4) asm volatile("s_waitcnt vmcnt(6)" ::: "memory"); else asm volatile("s_waitcnt vmcnt(4)" ::: "memory"); }
      else asm volatile("s_waitcnt vmcnt(0)" ::: "memory");
      __builtin_amdgcn_s_barrier();
      asm volatile("" ::: "memory");
      char* cur = smem_raw + cb * STAGE;
      cb = (cb == 2) ? 0 : cb + 1;
      bfx8 af[2][MT], bf[2][2];
      {
        const unsigned cofs = (unsigned)(cur - smem_raw);
        const unsigned aA0 = ldsA0 + cofs, aA1 = ldsA1 + cofs, aB0 = ldsB0 + cofs, aB1 = ldsB1 + cofs;
        asm volatile("ds_read_b128 %0, %1 offset:%2" : "=v"(bf[0][0]) : "v"(aB0), "n"(A_BYTES));
        asm volatile("ds_read_b128 %0, %1 offset:%2" : "=v"(bf[0][1]) : "v"(aB0), "n"(A_BYTES + 2048));
#pragma unroll
        for (int mi = 0; mi < MT; mi++) {
          if (mi == 0) asm volatile("ds_read_b128 %0, %1 offset:%2" : "=v"(af[0][0]) : "v"(aA0), "n"(0));
          if (mi == 1) asm volatile("ds_read_b128 %0, %1 offset:%2" : "=v"(af[0][1]) : "v"(aA0), "n"(2048));
          if (mi == 2) asm volatile("ds_read_b128 %0, %1 offset:%2" : "=v"(af[0][MT > 2 ? 2 : 0]) : "v"(aA0), "n"(4096));
          if (mi == 3) asm volatile("ds_read_b128 %0, %1 offset:%2" : "=v"(af[0][MT > 2 ? 3 : 0]) : "v"(aA0), "n"(6144));
        }
        asm volatile("ds_read_b128 %0, %1 offset:%2" : "=v"(bf[1][0]) : "v"(aB1), "n"(A_BYTES));
        asm volatile("ds_read_b128 %0, %1 offset:%2" : "=v"(bf[1][1]) : "v"(aB1), "n"(A_BYTES + 2048));
#pragma unroll
        for (int mi = 0; mi < MT; mi++) {
          if (mi == 0) asm volatile("ds_read_b128 %0, %1 offset:%2" : "=v"(af[1][0]) : "v"(aA1), "n"(0));
          if (mi == 1) asm volatile("ds_read_b128 %0, %1 offset:%2" : "=v"(af[1][1]) : "v"(aA1), "n"(2048));
          if (mi == 2) asm volatile("ds_read_b128 %0, %1 offset:%2" : "=v"(af[1][MT > 2 ? 2 : 0]) : "v"(aA1), "n"(4096));
          if (mi == 3) asm volatile("ds_read_b128 %0, %1 offset:%2" : "=v"(af[1][MT > 2 ? 3 : 0]) : "v"(aA1), "n"(6144));
        }
        if (kt + 2 < nk) {
          int nb = cb + 1; if (nb >= 3) nb -= 3;
          char* nxt = smem_raw + nb * STAGE;
          const size_t kc = REMAP ? (size_t)ycol((kt + 2) * 32) : (size_t)(kt + 2) * akstep;
  #pragma unroll
          for (int i = 0; i < NA; i++) __builtin_amdgcn_global_load_lds((const unsigned*)(ap[i] + kc), (unsigned*)(nxt + (w * NA + i) * 1024), 16, 0, 0);
  #pragma unroll
          for (int i = 0; i < 2; i++) __builtin_amdgcn_global_load_lds((const unsigned*)(bp[i] + (kt + 2) * bkstep), (unsigned*)(nxt + A_BYTES + (w * 2 + i) * 1024), 16, 0, 0);
        }
        if (MT == 4) asm volatile("s_waitcnt lgkmcnt(6)" : "+v"(bf[0][0]), "+v"(bf[0][1]), "+v"(af[0][0]), "+v"(af[0][1]), "+v"(af[0][MT > 2 ? 2 : 0]), "+v"(af[0][MT > 2 ? 3 : 1]));
        else asm volatile("s_waitcnt lgkmcnt(4)" : "+v"(bf[0][0]), "+v"(bf[0][1]), "+v"(af[0][0]), "+v"(af[0][1]));
#pragma unroll
        for (int mi = 0; mi < MT; mi++)
#pragma unroll
          for (int ni = 0; ni < 2; ni++)
            acc[ni][mi] = __builtin_amdgcn_mfma_f32_32x32x16_bf16(bf[0][ni], af[0][mi], acc[ni][mi], 0, 0, 0);
        __builtin_amdgcn_sched_barrier(0);
        if (MT == 4) asm volatile("s_waitcnt lgkmcnt(0)" : "+v"(bf[1][0]), "+v"(bf[1][1]), "+v"(af[1][0]), "+v"(af[1][1]), "+v"(af[1][MT > 2 ? 2 : 0]), "+v"(af[1][MT > 2 ? 3 : 1]));
        else asm volatile("s_waitcnt lgkmcnt(0)" : "+v"(bf[1][0]), "+v"(bf[1][1]), "+v"(af[1][0]), "+v"(af[1][1]));
#pragma unroll
        for (int mi = 0; mi < MT; mi++)
#pragma unroll
          for (int ni = 0; ni < 2; ni++)
            acc[ni][mi] = __builtin_amdgcn_mfma_f32_32x32x16_bf16(bf[1][ni], af[1][mi], acc[ni][mi], 0, 0, 0);
      }
      asm volatile("s_waitcnt lgkmcnt(0)" ::: "memory");
    }
    __syncthreads();
    sq += nslot;
    if (sq < cnt * ntn) GEMM_TILE_SETUP(sq)
    {
      char* cw = smem_raw + 2 * STAGE + w * (32 * 144);
      const int prow = lane >> 3, piece = lane & 7;
      const int n = cn0 + wn * 64 + piece * 8;
      const size_t crow = REMAP ? 32 : (size_t)ldc;
#pragma unroll
      for (int mi = 0; mi < MT; mi++) {
#pragma unroll
        for (int ni = 0; ni < 2; ni++)
#pragma unroll
          for (int q = 0; q < 4; q++) {
            u32x2 o = {pack2(acc[ni][mi][4 * q + 0], acc[ni][mi][4 * q + 1]), pack2(acc[ni][mi][4 * q + 2], acc[ni][mi][4 * q + 3])};
            *(u32x2*)(cw + r * 144 + (ni * 32 + 8 * q + 4 * hh) * 2) = o;
          }
        const int mrow = cm0 + wm * (MT * 32) + mi * 32 + prow;
        bf16_t* cp = REMAP ? C + ((size_t)(n >> 5) * NTOK + mrow) * 32 + (n & 31) : C + (size_t)mrow * ldc + n;
        if (n < N) {
#pragma unroll
          for (int j = 0; j < 4; j++) {
            const u32x4 v = *(const u32x4*)(cw + (j * 8 + prow) * 144 + piece * 16);
            *(u32x4*)(cp + (size_t)(j * 8) * crow) = v;
          }
        }
      }
    }
  }
#undef GEMM_TILE_SETUP
}


__device__ __forceinline__ void ph_gemm_out(const bf16_t* __restrict__ A, const bf16_t* __restrict__ Wt, bf16_t* __restrict__ C, char* smem_raw) {
  constexpr int N = DM, K = DMIX, lda = DIN;
  constexpr int A_BYTES = 128 * 128, STAGE = 2 * A_BYTES;
  int tid = threadIdx.x; asm volatile("" : "+v"(tid));
  const int lane = tid & 63, w = __builtin_amdgcn_readfirstlane(tid >> 6), wm = w & 1, wn = w >> 1;
  const int r = lane & 31, hh = lane >> 5;
  constexpr int ntn = N / 128, ntm = NTOK / 128, nk = K / 64;
  const int gi = lane >> 3, gpiece = (lane & 7) ^ gi;
  const unsigned ldsbase = (unsigned)(size_t)smem_raw;
  unsigned ldsA[4], ldsB[4];
#pragma unroll
  for (int ks = 0; ks < 4; ks++) {
    ldsA[ks] = ldsbase + (wm * 64 + r) * 128 + (((ks * 2 + hh) ^ (r & 7)) << 4);
    ldsB[ks] = ldsbase + A_BYTES + (wn * 64 + r) * 128 + (((ks * 2 + hh) ^ (r & 7)) << 4);
  }
  const int xcd = blockIdx.x & 7, cnt = (ntm - xcd + 7) >> 3, full = cnt >> 3, nslot = gridDim.x >> 3;
  int sq = blockIdx.x >> 3;
  int m0 = 0, n0 = 0;
  const bf16_t* ap[4];
  const bf16_t* bp[4];
#define OUT_TILE_COORD(q_)                                                                        \
  {                                                                                               \
    int g = (q_) / (8 * ntn), gm = 8, rem = (q_) - g * 8 * ntn;                                   \
    if (g >= full) { g = full; gm = cnt - 8 * full; rem = (q_) - full * 8 * ntn; }                \
    const int nt_ = rem / gm, mi_ = rem - nt_ * gm;                                               \
    m0 = ((g * 8 + mi_) * 8 + xcd) * 128; n0 = nt_ * 128;                                         \
    _Pragma("unroll") for (int i = 0; i < 4; i++) {                                               \
      ap[i] = A + (size_t)(m0 + (w * 4 + i) * 8 + gi) * lda + gpiece * 8;                         \
      bp[i] = Wt + (size_t)(n0 + (w * 4 + i) * 8 + gi) * 64 + gpiece * 8;                         \
    }                                                                                             \
  }
#define OUT_ISSUE(kt_, buf_)                                                                      \
  {                                                                                               \
    const int kc = ycol((kt_) * 64);                                                              \
    char* nxt = smem_raw + (buf_) * STAGE;                                                        \
    _Pragma("unroll") for (int i = 0; i < 4; i++)                                                 \
      __builtin_amdgcn_global_load_lds((const unsigned*)(ap[i] + kc), (unsigned*)(nxt + (w * 4 + i) * 1024), 16, 0, 0); \
    _Pragma("unroll") for (int i = 0; i < 4; i++)                                                 \
      __builtin_amdgcn_global_load_lds((const unsigned*)(bp[i] + (size_t)(kt_) * N * 64), (unsigned*)(nxt + A_BYTES + (w * 4 + i) * 1024), 16, 0, 0); \
  }
  __syncthreads();
  if (sq < cnt * ntn) { OUT_TILE_COORD(sq) OUT_ISSUE(0, 0) }
#pragma unroll 1
  while (sq < cnt * ntn) {
    const int cm0 = m0, cn0 = n0;
    f32x16 acc[2][2];
#pragma unroll
    for (int a = 0; a < 2; a++)
#pragma unroll
      for (int b = 0; b < 2; b++)
#pragma unroll
        for (int e = 0; e < 16; e++) acc[a][b][e] = 0.f;
#pragma unroll 1
    for (int kt = 0; kt < nk; kt++) {
      asm volatile("s_waitcnt vmcnt(0)" ::: "memory");
      __builtin_amdgcn_s_barrier();
      asm volatile("" ::: "memory");
      const unsigned cofs = (kt & 1) * STAGE;
      bfx8 af[4][2], bf[4][2];
#pragma unroll
      for (int ks = 0; ks < 4; ks++) {
        asm volatile("ds_read_b128 %0, %1 offset:%2" : "=v"(bf[ks][0]) : "v"(ldsB[ks] + cofs), "n"(0));
        asm volatile("ds_read_b128 %0, %1 offset:%2" : "=v"(bf[ks][1]) : "v"(ldsB[ks] + cofs), "n"(4096));
        asm volatile("ds_read_b128 %0, %1 offset:%2" : "=v"(af[ks][0]) : "v"(ldsA[ks] + cofs), "n"(0));
        asm volatile("ds_read_b128 %0, %1 offset:%2" : "=v"(af[ks][1]) : "v"(ldsA[ks] + cofs), "n"(4096));
      }
      if (kt + 1 < nk) OUT_ISSUE(kt + 1, (kt + 1) & 1)
      asm volatile("s_waitcnt lgkmcnt(8)" : "+v"(bf[0][0]), "+v"(bf[0][1]), "+v"(af[0][0]), "+v"(af[0][1]), "+v"(bf[1][0]), "+v"(bf[1][1]), "+v"(af[1][0]), "+v"(af[1][1]));
#pragma unroll
      for (int ks = 0; ks < 2; ks++)
#pragma unroll
        for (int mi = 0; mi < 2; mi++)
#pragma unroll
          for (int ni = 0; ni < 2; ni++)
            acc[ni][mi] = __builtin_amdgcn_mfma_f32_32x32x16_bf16(bf[ks][ni], af[ks][mi], acc[ni][mi], 0, 0, 0);
      __builtin_amdgcn_sched_barrier(0);
      asm volatile("s_waitcnt lgkmcnt(0)" : "+v"(bf[2][0]), "+v"(bf[2][1]), "+v"(af[2][0]), "+v"(af[2][1]), "+v"(bf[3][0]), "+v"(bf[3][1]), "+v"(af[3][0]), "+v"(af[3][1]));
#pragma unroll
      for (int ks = 2; ks < 4; ks++)
#pragma unroll
        for (int mi = 0; mi < 2; mi++)
#pragma unroll
          for (int ni = 0; ni < 2; ni++)
            acc[ni][mi] = __builtin_amdgcn_mfma_f32_32x32x16_bf16(bf[ks][ni], af[ks][mi], acc[ni][mi], 0, 0, 0);
    }
    __syncthreads();
    sq += nslot;
    if (sq < cnt * ntn) { OUT_TILE_COORD(sq) OUT_ISSUE(0, 0) }
    {
      char* cw = smem_raw + STAGE + w * (32 * 144);
      const int prow = lane >> 3, piece = lane & 7;
      const int n = cn0 + wn * 64 + piece * 8;
#pragma unroll
      for (int mi = 0; mi < 2; mi++) {
#pragma unroll
        for (int ni = 0; ni < 2; ni++)
#pragma unroll
          for (int q = 0; q < 4; q++) {
            u32x2 o = {pack2(acc[ni][mi][4 * q + 0], acc[ni][mi][4 * q + 1]), pack2(acc[ni][mi][4 * q + 2], acc[ni][mi][4 * q + 3])};
            *(u32x2*)(cw + r * 144 + (ni * 32 + 8 * q + 4 * hh) * 2) = o;
          }
        const int mrow = cm0 + wm * 64 + mi * 32 + prow;
        bf16_t* cp = C + ((size_t)(n >> 5) * NTOK + mrow) * 32 + (n & 31);
#pragma unroll
        for (int j = 0; j < 4; j++) {
          const u32x4 v = *(const u32x4*)(cw + (j * 8 + prow) * 144 + piece * 16);
          *(u32x4*)(cp + (size_t)(j * 8) * 32) = v;
        }
      }
    }
  }
#undef OUT_TILE_COORD
#undef OUT_ISSUE
}

__device__ __forceinline__ void ph_foxscan(const Prm& p, int layer) {
  const int lane = threadIdx.x & 63;
  const int wave = (blockIdx.x * blockDim.x + threadIdx.x) >> 6;
  const int nw = (gridDim.x * blockDim.x) >> 6;
  for (int it = wave; it < NB * 8; it += nw) {
    int b = it >> 3, h = it & 7;
    float bias = p.b_f[layer * 8 + h];
    float carry = 0.f;
    for (int t0 = 0; t0 < LSEQ; t0 += 64) {
      int t = t0 + lane;
      float lf = 0.f;
      if (t >= TV0) lf = logsigf_(bf2f(p.proj[(size_t)(b * LSEQ + t) * DIN + C_FF + h]) + bias);
#pragma unroll
      for (int off = 1; off < 64; off <<= 1) {
        float y = __shfl_up(lf, off);
        if (lane >= off) lf += y;
      }
      lf += carry;
      p.cfox[(size_t)it * LSEQ + t] = lf;
      carry = __shfl(lf, 63);
    }
  }
}

__device__ __forceinline__ void ph_fox_naive(const Prm& p, int bid, int nblk) {
  const int ngroups = NB * 8 * (LSEQ / 256) + NB * 8;
  const int gpb = (LSEQ + 255) / 256;
  (void)ngroups;
  for (int g = bid; g < NB * 8 * gpb; g += nblk) {
    int bh = g / gpb, tg = gpb - 1 - (g % gpb);
    int b = bh >> 3, h = bh & 7;
    int t = tg * 256 + threadIdx.x;
    if (t >= LSEQ) continue;
    bf16_t* qrow = p.proj + (size_t)(b * LSEQ + t) * DIN + C_FQ + h * 64;
    if (t < TV0) {
      for (int d = 0; d < 64; d++) qrow[d] = 0;
      continue;
    }
    float q[64], o[64];
#pragma unroll
    for (int d = 0; d < 64; d++) { q[d] = bf2f(qrow[d]) * 0.125f; o[d] = 0.f; }
    const float* cr = p.cfox + (size_t)bh * LSEQ;
    float ct = cr[t], m = -1e30f, l = 0.f;
    for (int s = TV0; s <= t; s++) {
      const uint4* kr = (const uint4*)(p.proj + (size_t)(b * LSEQ + s) * DIN + C_FK + h * 64);
      const uint4* vr = (const uint4*)(p.proj + (size_t)(b * LSEQ + s) * DIN + C_FV + h * 64);
      float dot = 0.f;
#pragma unroll
      for (int i = 0; i < 8; i++) {
        uint4 u = kr[i];
        dot += q[i * 8 + 0] * __uint_as_float(u.x << 16) + q[i * 8 + 1] * __uint_as_float(u.x & 0xffff0000u)
             + q[i * 8 + 2] * __uint_as_float(u.y << 16) + q[i * 8 + 3] * __uint_as_float(u.y & 0xffff0000u)
             + q[i * 8 + 4] * __uint_as_float(u.z << 16) + q[i * 8 + 5] * __uint_as_float(u.z & 0xffff0000u)
             + q[i * 8 + 6] * __uint_as_float(u.w << 16) + q[i * 8 + 7] * __uint_as_float(u.w & 0xffff0000u);
      }
      float sc = dot + ct - cr[s];
      float mn = fmaxf(m, sc);
      float al = __expf(m - mn), pe = __expf(sc - mn);
      l = l * al + pe; m = mn;
#pragma unroll
      for (int i = 0; i < 8; i++) {
        uint4 u = vr[i];
        o[i * 8 + 0] = o[i * 8 + 0] * al + pe * __uint_as_float(u.x << 16);
        o[i * 8 + 1] = o[i * 8 + 1] * al + pe * __uint_as_float(u.x & 0xffff0000u);
        o[i * 8 + 2] = o[i * 8 + 2] * al + pe * __uint_as_float(u.y << 16);
        o[i * 8 + 3] = o[i * 8 + 3] * al + pe * __uint_as_float(u.y & 0xffff0000u);
        o[i * 8 + 4] = o[i * 8 + 4] * al + pe * __uint_as_float(u.z << 16);
        o[i * 8 + 5] = o[i * 8 + 5] * al + pe * __uint_as_float(u.z & 0xffff0000u);
        o[i * 8 + 6] = o[i * 8 + 6] * al + pe * __uint_as_float(u.w << 16);
        o[i * 8 + 7] = o[i * 8 + 7] * al + pe * __uint_as_float(u.w & 0xffff0000u);
      }
    }
    float inv = 1.f / l;
    const bf16_t* grow = p.proj + (size_t)(b * LSEQ + t) * DIN + C_FG + h * 64;
#pragma unroll
    for (int d = 0; d < 64; d++) qrow[d] = f2bf(o[d] * inv * siluf_(bf2f(grow[d])));
  }
}

__device__ __forceinline__ void ph_gla_naive(const Prm& p, int layer, float* smem) {
  float (*sa)[64] = (float (*)[64])smem;
  float (*sq)[64] = (float (*)[64])(smem + 1024);
  float (*sk)[64] = (float (*)[64])(smem + 2048);
  float (*sred)[2] = (float (*)[2])(smem + 3072);
  const int tid = threadIdx.x;
  for (int it = blockIdx.x; it < NB * 4; it += gridDim.x) {
    int b = it >> 2, h = it & 3;
    float S[64];
#pragma unroll
    for (int d = 0; d < 64; d++) S[d] = 0.f;
    const float* wa = p.w_a2 + (size_t)layer * 16 * 256;
    const float* ba = p.b_a + layer * 256;
    float gn = (tid < 128) ? p.gla_g[layer * 512 + h * 128 + tid] : 0.f;
    for (int t0 = 0; t0 < LSEQ; t0 += 16) {
      __syncthreads();
      for (int e = tid; e < 1024; e += blockDim.x) {
        int tt = e >> 6, d = e & 63, t = t0 + tt;
        const bf16_t* row = p.proj + (size_t)(b * LSEQ + t) * DIN;
        float xa = ba[h * 64 + d];
#pragma unroll
        for (int r = 0; r < 16; r++) xa += bf2f(row[C_GA + r]) * wa[r * 256 + h * 64 + d];
        sa[tt][d] = __expf(logsigf_(xa) * (1.f / 16.f));
        sq[tt][d] = bf2f(row[C_GQ + h * 64 + d]) * 0.125f;
        sk[tt][d] = (t >= TV0) ? bf2f(row[C_GK + h * 64 + d]) : 0.f;
      }
      __syncthreads();
      float o[16];
      if (tid < 128) {
#pragma unroll
        for (int tt = 0; tt < 16; tt++) {
          float v = bf2f(p.proj[(size_t)(b * LSEQ + t0 + tt) * DIN + C_GV + h * 128 + tid]);
          float acc = 0.f;
#pragma unroll
          for (int d = 0; d < 64; d++) {
            S[d] = sa[tt][d] * S[d] + sk[tt][d] * v;
            acc += sq[tt][d] * S[d];
          }
          o[tt] = acc;
          float ssq = wave_sum(acc * acc);
          if ((tid & 63) == 0) sred[tt][tid >> 6] = ssq;
        }
      }
      __syncthreads();
      if (tid < 128) {
#pragma unroll
        for (int tt = 0; tt < 16; tt++) {
          int t = t0 + tt;
          float ms = (sred[tt][0] + sred[tt][1]) * (1.f / 128.f);
          bf16_t* row = p.proj + (size_t)(b * LSEQ + t) * DIN;
          float y = o[tt] * rsqrtf(ms + 1e-6f) * gn * siluf_(bf2f(row[C_GG + h * 128 + tid]));
          if (t < TV0) y = 0.f;
          row[C_YG + h * 128 + tid] = f2bf(y);
        }
      }
    }
  }
}

__device__ __forceinline__ void ph_lru_naive_b(const Prm& p, int layer, float* smem, int bid0) {
  float (*sx)[128] = (float (*)[128])smem;
  const int tid = threadIdx.x;
  for (int it = bid0; it < NB * 8; it += gridDim.x) {
    int b = it >> 3, hb = it & 7;
    int j = tid & 127, c = hb * 128 + j;
    const float* cw = p.conv_w + (size_t)layer * 4 * 1024;
    float w0 = cw[c], w1 = cw[1024 + c], w2 = cw[2048 + c], w3 = cw[3072 + c], cb = p.conv_b[layer * 1024 + c];
    float br = p.b_r[layer * 1024 + c], bi = p.b_i[layer * 1024 + c];
    float lamv = p.lam[layer * 1024 + c];
    float sp = fmaxf(-lamv, 0.f) + log1pf(__expf(-fabsf(lamv)));
    const float* wr = p.w_r + ((size_t)layer * 8 + hb) * 128 * 128;
    const float* wi = p.w_i + ((size_t)layer * 8 + hb) * 128 * 128;
    float x1 = 0.f, x2 = 0.f, x3 = 0.f, hst = 0.f;
    for (int t0 = 0; t0 < LSEQ; t0 += 8) {
      float xc[8];
      __syncthreads();
      if (tid < 128) {
#pragma unroll
        for (int tt = 0; tt < 8; tt++) {
          int t = t0 + tt;
          float x0 = bf2f(p.proj[(size_t)(b * LSEQ + t) * DIN + C_LX + c]);
          float v = w0 * x3 + w1 * x2 + w2 * x1 + w3 * x0 + cb;
          if (t < TV0) v = 0.f;
          x3 = x2; x2 = x1; x1 = x0;
          xc[tt] = v; sx[tt][j] = v;
        }
      }
      __syncthreads();
      if (tid < 128) {
        float ar[8], ai[8];
#pragma unroll
        for (int tt = 0; tt < 8; tt++) { ar[tt] = br; ai[tt] = bi; }
        for (int i = 0; i < 128; i++) {
          float a = wr[i * 128 + j], bb = wi[i * 128 + j];
#pragma unroll
          for (int tt = 0; tt < 8; tt++) { float xv = sx[tt][i]; ar[tt] += xv * a; ai[tt] += xv * bb; }
        }
#pragma unroll
        for (int tt = 0; tt < 8; tt++) {
          int t = t0 + tt;
          float r = sigmoidf_(ar[tt]), ig = sigmoidf_(ai[tt]);
          float la = -8.f * r * sp;
          float a = __expf(la);
          float u = sqrtf(-expm1f(2.f * la)) * (ig * xc[tt]);
          hst = a * hst + u;
          bf16_t* row = p.proj + (size_t)(b * LSEQ + t) * DIN;
          float y = hst * siluf_(bf2f(row[C_LG + c]));
          if (t < TV0) y = 0.f;
          row[C_YL + c] = f2bf(y);
        }
      }
    }
  }
}


#define NCH 130
#define LXS 136
template <bool PASSC>
__device__ __forceinline__ void ph_lru(const Prm& p, int layer, char* smem, const int item) {
  bf16_t* sX = (bf16_t*)smem;
  int tid = threadIdx.x; asm volatile("" : "+v"(tid));
  const int lane = tid & 63, w = tid >> 6, r = lane & 31, hh = lane >> 5;
  const int taur = 16 * ((r >> 2) & 1) + (r & 3) + 4 * (r >> 3);
  const int cp = tid & 63, tg = tid >> 6;
  {
    const int hb = item & 7, j = (item >> 3) % NCH, b = item / (8 * NCH);
    const int t0 = j * 64;
    __syncthreads();
    const int wrow = lane >> 4, wpc = lane & 15;
    const bf16_t* wgr = p.wt_r + ((size_t)(layer * 8 + hb) * 128 + w * 32 + wrow) * 128 + wpc * 8;
    const bf16_t* wgi = p.wt_i + ((size_t)(layer * 8 + hb) * 128 + w * 32 + wrow) * 128 + wpc * 8;
    bf16_t* sW = (bf16_t*)(smem + 64 * LXS * 2) + w * (32 * LXS);
    u32x4 wreg[8];
#pragma unroll
    for (int i = 0; i < 8; i++) wreg[i] = *(const u32x4*)(wgr + (size_t)(4 * i) * 128);
    {
      const int pc8 = tid & 15, tq4 = tid >> 4;
      const int c0 = hb * 128 + pc8 * 8;
      const float* cw = p.conv_w + (size_t)layer * 4 * 1024 + c0;
      float wv[4][8], cbv[8];
#pragma unroll
      for (int tp = 0; tp < 4; tp++) {
        const f32x4 wa = *(const f32x4*)(cw + tp * 1024), wb = *(const f32x4*)(cw + tp * 1024 + 4);
#pragma unroll
        for (int k = 0; k < 4; k++) { wv[tp][k] = wa[k]; wv[tp][4 + k] = wb[k]; }
      }
      {
        const f32x4 ba = *(const f32x4*)(p.conv_b + layer * 1024 + c0), bb = *(const f32x4*)(p.conv_b + layer * 1024 + c0 + 4);
#pragma unroll
        for (int k = 0; k < 4; k++) { cbv[k] = ba[k]; cbv[4 + k] = bb[k]; }
      }
      const int tb = t0 + tq4 * 4;
      const bf16_t* base = p.proj + (size_t)b * LSEQ * DIN + C_LX + c0;
      u32x4 xr[7];
#pragma unroll
      for (int i = 0; i < 7; i++) {
        const int t = tb - 3 + i;
        xr[i] = (t >= 0) ? *(const u32x4*)(base + (size_t)t * DIN) : (u32x4){0u, 0u, 0u, 0u};
      }
#pragma unroll
      for (int tt = 0; tt < 4; tt++) {
        u32x4 o;
#pragma unroll
        for (int k = 0; k < 4; k++) {
          typedef float f32x2c __attribute__((ext_vector_type(2)));
          f32x2c v = {cbv[2 * k], cbv[2 * k + 1]};
#pragma unroll
          for (int tp = 0; tp < 4; tp++) {
            const unsigned u = xr[tt + tp][k];
            const f32x2c x = {__uint_as_float(u << 16), __uint_as_float(u & 0xffff0000u)};
            const f32x2c wp = {wv[tp][2 * k], wv[tp][2 * k + 1]};
            v = wp * x + v;
          }
          o[k] = pack2(v[0], v[1]);
        }
        if (tb + tt < TV0) { o[0] = 0u; o[1] = 0u; o[2] = 0u; o[3] = 0u; }
        *(u32x4*)(sX + (tq4 * 4 + tt) * LXS + pc8 * 8) = o;
      }
    }
    __syncthreads();
    const int jc = w * 32 + r, c = hb * 128 + jc;
    f32x16 R0, R1, I0, I1;
#pragma unroll
    for (int e = 0; e < 16; e++) { R0[e] = 0.f; R1[e] = 0.f; I0[e] = 0.f; I1[e] = 0.f; }
    {
#pragma unroll
      for (int i = 0; i < 8; i++) *(u32x4*)(sW + (wrow + 4 * i) * LXS + wpc * 8) = wreg[i];
#pragma unroll
      for (int i = 0; i < 8; i++) wreg[i] = *(const u32x4*)(wgi + (size_t)(4 * i) * 128);
#pragma unroll
      for (int ks = 0; ks < 8; ks++) {
        const bfx8 bR = *(const bfx8*)(sW + r * LXS + ks * 16 + hh * 8);
        const bfx8 a0 = *(const bfx8*)(sX + taur * LXS + ks * 16 + hh * 8);
        const bfx8 a1 = *(const bfx8*)(sX + (32 + taur) * LXS + ks * 16 + hh * 8);
        R0 = __builtin_amdgcn_mfma_f32_32x32x16_bf16(a0, bR, R0, 0, 0, 0);
        R1 = __builtin_amdgcn_mfma_f32_32x32x16_bf16(a1, bR, R1, 0, 0, 0);
      }
      asm volatile("s_waitcnt lgkmcnt(0)" ::: "memory");
#pragma unroll
      for (int i = 0; i < 8; i++) *(u32x4*)(sW + (wrow + 4 * i) * LXS + wpc * 8) = wreg[i];
#pragma unroll
      for (int ks = 0; ks < 8; ks++) {
        const bfx8 bI = *(const bfx8*)(sW + r * LXS + ks * 16 + hh * 8);
        const bfx8 a0 = *(const bfx8*)(sX + taur * LXS + ks * 16 + hh * 8);
        const bfx8 a1 = *(const bfx8*)(sX + (32 + taur) * LXS + ks * 16 + hh * 8);
        I0 = __builtin_amdgcn_mfma_f32_32x32x16_bf16(a0, bI, I0, 0, 0, 0);
        I1 = __builtin_amdgcn_mfma_f32_32x32x16_bf16(a1, bI, I1, 0, 0, 0);
      }
    }
    const float br = p.b_r[layer * 1024 + c], bi = p.b_i[layer * 1024 + c];
    const float lamv = p.lam[layer * 1024 + c];
    const float sp8 = -8.f * 1.4426950408889634f * (fmaxf(-lamv, 0.f) + log1pf(__expf(-fabsf(lamv))));
    const float brl = -1.4426950408889634f * br, bil = -1.4426950408889634f * bi;
    typedef float f32x2 __attribute__((ext_vector_type(2)));
    f32x2 Pv = {1.f, 1.f}, Hv = {0.f, 0.f};
    const f32x2 nl2 = {-1.4426950408889634f, -1.4426950408889634f}, one2 = {1.f, 1.f};
    const f32x2 brl2 = {brl, brl}, bil2 = {bil, bil}, sp82 = {sp8, sp8};
#pragma unroll
    for (int e = 0; e < 16; e++) {
      const f32x2 Rv = {R0[e], R1[e]}, Iv = {I0[e], I1[e]};
      f32x2 er = Rv * nl2 + brl2, ei = Iv * nl2 + bil2;
      er = (f32x2){__builtin_amdgcn_exp2f(er[0]), __builtin_amdgcn_exp2f(er[1])} + one2;
      ei = (f32x2){__builtin_amdgcn_exp2f(ei[0]), __builtin_amdgcn_exp2f(ei[1])} + one2;
      const f32x2 rr = {__builtin_amdgcn_rcpf(er[0]), __builtin_amdgcn_rcpf(er[1])};
      const f32x2 ig = {__builtin_amdgcn_rcpf(ei[0]), __builtin_amdgcn_rcpf(ei[1])};
      const f32x2 la = rr * sp82;
      const f32x2 a = {__builtin_amdgcn_exp2f(la[0]), __builtin_amdgcn_exp2f(la[1])};
      const f32x2 xv = {bf2f(sX[(16 * hh + e) * LXS + jc]), bf2f(sX[(32 + 16 * hh + e) * LXS + jc])};
      const f32x2 om = one2 - a * a;
      const f32x2 sq = {__builtin_amdgcn_sqrtf(om[0]), __builtin_amdgcn_sqrtf(om[1])};
      const f32x2 u = sq * ig * xv;
      R0[e] = a[0]; R1[e] = a[1]; I0[e] = u[0]; I1[e] = u[1];
      Pv = Pv * a; Hv = a * Hv + u;
    }
    const float P0 = Pv[0], P1 = Pv[1], H0 = Hv[0], H1 = Hv[1];
    const float oP0 = __shfl_xor(P0, 32), oH0 = __shfl_xor(H0, 32), oP1 = __shfl_xor(P1, 32), oH1 = __shfl_xor(H1, 32);
    const float P00 = hh ? oP0 : P0, H00 = hh ? oH0 : H0, P01 = hh ? P0 : oP0, H01 = hh ? H0 : oH0;
    const float P10 = hh ? oP1 : P1, H10 = hh ? oH1 : H1, P11 = hh ? P1 : oP1, H11 = hh ? H1 : oH1;
    const size_t aidx = ((size_t)b * NCH + j) * 1024 + c;
    if (!PASSC) {
      if (hh == 0) {
        p.lruP[aidx] = P00 * P01 * P10 * P11;
        p.lruH[aidx] = ((H00 * P01 + H01) * P10 + H10) * P11 + H11;
      }
    } else {
      const float s00 = p.lruH[aidx];
      const float s01 = P00 * s00 + H00;
      const float s10 = P01 * s01 + H01;
      const float s11 = P10 * s10 + H10;
      float h0 = hh ? s01 : s00, h1 = hh ? s11 : s10;
      const int prow = tid >> 4, pc = tid & 15;
      bf16_t* ob = p.proj + ((size_t)b * LSEQ + t0 + prow) * DIN + hb * 128 + pc * 8;
      u32x4 lgv[4];
#pragma unroll
      for (int i = 0; i < 4; i++) lgv[i] = *(const u32x4*)(ob + (size_t)(16 * i) * DIN + C_LG);
      __syncthreads();
#pragma unroll
      for (int e = 0; e < 16; e++) {
        h0 = R0[e] * h0 + I0[e];
        h1 = R1[e] * h1 + I1[e];
        sX[(16 * hh + e) * LXS + jc] = f2bf(h0);
        sX[(32 + 16 * hh + e) * LXS + jc] = f2bf(h1);
      }
      __syncthreads();
#pragma unroll
      for (int i = 0; i < 4; i++) {
        const int row = prow + 16 * i;
        const u32x4 hv = *(const u32x4*)(sX + row * LXS + pc * 8);
        u32x4 o;
#pragma unroll
        for (int k = 0; k < 4; k++) {
          float ya = __uint_as_float(hv[k] << 16) * siluf_(__uint_as_float(lgv[i][k] << 16));
          float yb = __uint_as_float(hv[k] & 0xffff0000u) * siluf_(__uint_as_float(lgv[i][k] & 0xffff0000u));
          o[k] = pack2(ya, yb);
        }
        if (t0 + row < TV0) { o[0] = 0u; o[1] = 0u; o[2] = 0u; o[3] = 0u; }
        *(u32x4*)(ob + (size_t)(16 * i) * DIN + C_YL) = o;
      }
    }
  }
}

__device__ __forceinline__ void ph_lru_scan(const Prm& p, int gtid, int gthreads) {
  for (int i = gtid; i < NB * 1024; i += gthreads) {
    int b = i >> 10, c = i & 1023;
    float s = 0.f;
    size_t base = (size_t)b * NCH * 1024 + c;
    for (int j0 = 0; j0 < NCH; j0 += 13) {
      float Pv[13], Hv[13];
#pragma unroll
      for (int k = 0; k < 13; k++) { Pv[k] = p.lruP[base + (size_t)(j0 + k) * 1024]; Hv[k] = p.lruH[base + (size_t)(j0 + k) * 1024]; }
#pragma unroll
      for (int k = 0; k < 13; k++) { p.lruH[base + (size_t)(j0 + k) * 1024] = s; s = Pv[k] * s + Hv[k]; }
    }
  }
}


#define GS 72
template <bool PASSC>
__device__ __forceinline__ void ph_gla(const Prm& p, int layer, char* smem, const int item) {
  bf16_t* sQ = (bf16_t*)smem;
  bf16_t* sK = sQ + 64 * GS;
  bf16_t* sVt = sK + 64 * GS;
  bf16_t* sP = sVt + 128 * GS;
  bf16_t* sSt = sP + 64 * GS;
  float* sTot = (float*)(sSt + 128 * GS);
  float* sRed = sTot + 256;
  int tid = threadIdx.x; asm volatile("" : "+v"(tid));
  const int lane = tid & 63, w = tid >> 6, r = lane & 31, hh = lane >> 5;
  const int d = (w >> 1) * 32 + r, tg = (w & 1) * 2 + hh;
  {
    const int bh = item % 16, j = item / 16;
    const int b = bh >> 2, h = bh & 3;
    const int t0 = j * 64;
    const bf16_t* pb = p.proj + (size_t)(b * LSEQ + t0) * DIN;
    __syncthreads();
    float Bv[16];
    float* gBp = p.gB + (((size_t)bh * NCH + j) * 64 + tg * 16) * 64 + d;
    if (PASSC) {
#pragma unroll
      for (int tt = 0; tt < 16; tt++) Bv[tt] = gBp[tt * 64];
    } else {
      const int taur = 16 * ((r >> 2) & 1) + (r & 3) + 4 * (r >> 3);
      const bfx8 av = *(const bfx8*)(pb + (size_t)((w & 1) * 32 + taur) * DIN + C_GA + hh * 8);
      const float* wap = p.w_a2 + (size_t)layer * 16 * 256 + (size_t)(hh * 8) * 256 + h * 64 + d;
      union { bfx8 v; unsigned u[4]; } bw;
#pragma unroll
      for (int q = 0; q < 4; q++) bw.u[q] = pack2(wap[(2 * q) * 256], wap[(2 * q + 1) * 256]);
      f32x16 xg;
#pragma unroll
      for (int e = 0; e < 16; e++) xg[e] = 0.f;
      xg = __builtin_amdgcn_mfma_f32_32x32x16_bf16(av, bw.v, xg, 0, 0, 0);
      const float ba = p.b_a[layer * 256 + h * 64 + d];
      float cum = 0.f;
#pragma unroll
      for (int tt = 0; tt < 16; tt++) {
        cum += logsigf_(xg[tt] + ba) * (1.f / 16.f);
        Bv[tt] = cum;
      }
      sTot[tg * 64 + d] = cum;
    }
#pragma unroll
    for (int i = 0; i < 4; i++) {
      const int c8 = w + 4 * i, tk = tid & 63;
      u32x4 v = *(const u32x4*)(pb + (size_t)tk * DIN + C_GV + h * 128 + c8 * 8);
#pragma unroll
      for (int q = 0; q < 4; q++) {
        sVt[(c8 * 8 + 2 * q) * GS + tk] = (bf16_t)(v[q] & 0xffffu);
        sVt[(c8 * 8 + 2 * q + 1) * GS + tk] = (bf16_t)(v[q] >> 16);
      }
    }
    {
#pragma unroll
      for (int i = 0; i < 2; i++) {
        const int id = tid + 256 * i, row = id >> 3, ch = id & 7;
        *(u32x4*)(sK + row * GS + ch * 8) = *(const u32x4*)(pb + (size_t)row * DIN + C_GK + h * 64 + ch * 8);
        if (PASSC) *(u32x4*)(sQ + row * GS + ch * 8) = *(const u32x4*)(pb + (size_t)row * DIN + C_GQ + h * 64 + ch * 8);
      }
    }
    __syncthreads();
    float offs = 0.f, blast = 0.f;
    if (!PASSC) {
#pragma unroll
      for (int g = 0; g < 4; g++) { float v = sTot[g * 64 + d]; blast += v; if (g < tg) offs += v; }
#pragma unroll
      for (int tt = 0; tt < 16; tt++) gBp[tt * 64] = Bv[tt] + offs;
    }
    if (!PASSC) {
      unsigned pk[8];
#pragma unroll
      for (int tt = 0; tt < 16; tt += 2) {
        int ta = t0 + tg * 16 + tt;
        float k0 = (ta >= TV0) ? bf2f(sK[(tg * 16 + tt) * GS + d]) : 0.f;
        float k1 = (ta + 1 >= TV0) ? bf2f(sK[(tg * 16 + tt + 1) * GS + d]) : 0.f;
        pk[tt >> 1] = pack2(k0 * fexpf_(blast - (Bv[tt] + offs)), k1 * fexpf_(blast - (Bv[tt + 1] + offs)));
      }
      u32x4 o0 = {pk[0], pk[1], pk[2], pk[3]}, o1 = {pk[4], pk[5], pk[6], pk[7]};
      *(u32x4*)(sQ + d * GS + tg * 16) = o0;
      *(u32x4*)(sQ + d * GS + tg * 16 + 8) = o1;
      if (tg == 0) p.gdec[((size_t)bh * NCH + j) * 64 + d] = fexpf_(blast);
      __syncthreads();
      f32x16 a0, a1;
#pragma unroll
      for (int e = 0; e < 16; e++) { a0[e] = 0.f; a1[e] = 0.f; }
#pragma unroll
      for (int ks = 0; ks < 4; ks++) {
        const bfx8 av = *(const bfx8*)(sVt + (w * 32 + r) * GS + ks * 16 + hh * 8);
        const bfx8 b0 = *(const bfx8*)(sQ + r * GS + ks * 16 + hh * 8);
        const bfx8 b1 = *(const bfx8*)(sQ + (32 + r) * GS + ks * 16 + hh * 8);
        a0 = __builtin_amdgcn_mfma_f32_32x32x16_bf16(av, b0, a0, 0, 0, 0);
        a1 = __builtin_amdgcn_mfma_f32_32x32x16_bf16(av, b1, a1, 0, 0, 0);
      }
      bf16_t* gs = p.gstate + ((size_t)bh * NCH + j) * 8192;
#pragma unroll
      for (int e = 0; e < 16; e++) {
        int dv = w * 32 + (e & 3) + 8 * (e >> 2) + 4 * hh;
        gs[dv * 64 + r] = f2bf(a0[e]);
        gs[dv * 64 + 32 + r] = f2bf(a1[e]);
      }
    } else {
#pragma unroll
      for (int tt = 0; tt < 16; tt++) {
        int tl = tg * 16 + tt, ta = t0 + tl;
        float bb = Bv[tt] + offs;
        float qv = bf2f(sQ[tl * GS + d]) * 0.125f;
        float kv = (ta >= TV0) ? bf2f(sK[tl * GS + d]) : 0.f;
        sQ[tl * GS + d] = f2bf(qv * fexpf_(bb));
        sK[tl * GS + d] = f2bf(kv * fexpf_(-bb));
      }
      {
        const bf16_t* gs = p.gstate + ((size_t)bh * NCH + j) * 8192;
#pragma unroll
        for (int i = 0; i < 4; i++) {
          int id = tid + 256 * i, dv = id >> 3, d8 = id & 7;
          *(u32x4*)(sSt + dv * GS + d8 * 8) = *(const u32x4*)(gs + dv * 64 + d8 * 8);
        }
      }
      __syncthreads();
      {
        const int tqT = w & 1, tsT = w >> 1;
        f32x16 pa;
#pragma unroll
        for (int e = 0; e < 16; e++) pa[e] = 0.f;
        if (tsT <= tqT) {
#pragma unroll
          for (int ks = 0; ks < 4; ks++) {
            const bfx8 ak = *(const bfx8*)(sK + (tsT * 32 + r) * GS + ks * 16 + hh * 8);
            const bfx8 bq = *(const bfx8*)(sQ + (tqT * 32 + r) * GS + ks * 16 + hh * 8);
            pa = __builtin_amdgcn_mfma_f32_32x32x16_bf16(ak, bq, pa, 0, 0, 0);
          }
        }
        const int tq = tqT * 32 + r;
#pragma unroll
        for (int q = 0; q < 4; q++) {
          int ts = tsT * 32 + 8 * q + 4 * hh;
          float v0 = (ts + 0 <= tq) ? pa[4 * q + 0] : 0.f, v1 = (ts + 1 <= tq) ? pa[4 * q + 1] : 0.f;
          float v2 = (ts + 2 <= tq) ? pa[4 * q + 2] : 0.f, v3 = (ts + 3 <= tq) ? pa[4 * q + 3] : 0.f;
          u32x2 o = {pack2(v0, v1), pack2(v2, v3)};
          *(u32x2*)(sP + tq * GS + ts) = o;
        }
      }
      __syncthreads();
      {
        const int tqT = w & 1, dvT = (w >> 1) * 2;
        f32x16 o0, o1;
#pragma unroll
        for (int e = 0; e < 16; e++) { o0[e] = 0.f; o1[e] = 0.f; }
#pragma unroll
        for (int ks = 0; ks < 4; ks++) {
          const bfx8 bp = *(const bfx8*)(sP + (tqT * 32 + r) * GS + ks * 16 + hh * 8);
          const bfx8 v0 = *(const bfx8*)(sVt + (dvT * 32 + r) * GS + ks * 16 + hh * 8);
          const bfx8 v1 = *(const bfx8*)(sVt + (dvT * 32 + 32 + r) * GS + ks * 16 + hh * 8);
          o0 = __builtin_amdgcn_mfma_f32_32x32x16_bf16(v0, bp, o0, 0, 0, 0);
          o1 = __builtin_amdgcn_mfma_f32_32x32x16_bf16(v1, bp, o1, 0, 0, 0);
        }
#pragma unroll
        for (int ks = 0; ks < 4; ks++) {
          const bfx8 bq = *(const bfx8*)(sQ + (tqT * 32 + r) * GS + ks * 16 + hh * 8);
          const bfx8 s0 = *(const bfx8*)(sSt + (dvT * 32 + r) * GS + ks * 16 + hh * 8);
          const bfx8 s1 = *(const bfx8*)(sSt + (dvT * 32 + 32 + r) * GS + ks * 16 + hh * 8);
          o0 = __builtin_amdgcn_mfma_f32_32x32x16_bf16(s0, bq, o0, 0, 0, 0);
          o1 = __builtin_amdgcn_mfma_f32_32x32x16_bf16(s1, bq, o1, 0, 0, 0);
        }
        float ssq = 0.f;
#pragma unroll
        for (int e = 0; e < 16; e++) ssq += o0[e] * o0[e] + o1[e] * o1[e];
        ssq += __shfl_xor(ssq, 32);
        const int tq = tqT * 32 + r;
        if (hh == 0) sRed[(w >> 1) * 64 + tq] = ssq;
        __syncthreads();
        const float tot = sRed[tq] + sRed[64 + tq];
        const float rs = rsqrtf(tot * (1.f / 128.f) + 1e-6f);
        bf16_t* sO = sSt;
        const int prow = tid >> 4, pc = tid & 15;
        bf16_t* ob = p.proj + (size_t)(b * LSEQ + t0 + prow) * DIN + h * 128 + pc * 8;
        u32x4 ggv[4];
#pragma unroll
        for (int i = 0; i < 4; i++) ggv[i] = *(const u32x4*)(ob + (size_t)(16 * i) * DIN + C_GG);
        const f32x4 gna = *(const f32x4*)(p.gla_g + layer * 512 + h * 128 + pc * 8);
        const f32x4 gnb = *(const f32x4*)(p.gla_g + layer * 512 + h * 128 + pc * 8 + 4);
#pragma unroll
        for (int q = 0; q < 4; q++) {
          u32x2 w0 = {pack2(o0[4 * q + 0] * rs, o0[4 * q + 1] * rs), pack2(o0[4 * q + 2] * rs, o0[4 * q + 3] * rs)};
          u32x2 w1 = {pack2(o1[4 * q + 0] * rs, o1[4 * q + 1] * rs), pack2(o1[4 * q + 2] * rs, o1[4 * q + 3] * rs)};
          *(u32x2*)(sO + tq * 136 + dvT * 32 + 8 * q + 4 * hh) = w0;
          *(u32x2*)(sO + tq * 136 + (dvT + 1) * 32 + 8 * q + 4 * hh) = w1;
        }
        __syncthreads();
#pragma unroll
        for (int i = 0; i < 4; i++) {
          const int row = prow + 16 * i;
          const u32x4 ov = *(const u32x4*)(sO + row * 136 + pc * 8);
          u32x4 o;
#pragma unroll
          for (int k = 0; k < 4; k++) {
            const float ga_ = (k < 2) ? gna[2 * k] : gnb[2 * k - 4], gb_ = (k < 2) ? gna[2 * k + 1] : gnb[2 * k - 3];
            float ya = __uint_as_float(ov[k] << 16) * ga_ * siluf_(__uint_as_float(ggv[i][k] << 16));
            float yb = __uint_as_float(ov[k] & 0xffff0000u) * gb_ * siluf_(__uint_as_float(ggv[i][k] & 0xffff0000u));
            o[k] = pack2(ya, yb);
          }
          if (t0 + row < TV0) { o[0] = 0u; o[1] = 0u; o[2] = 0u; o[3] = 0u; }
          *(u32x4*)(ob + (size_t)(16 * i) * DIN + C_YG) = o;
        }
      }
    }
  }
}

__device__ __forceinline__ void ph_gla_scan(const Prm& p, int gtid, int gthreads) {
  for (int i = gtid; i < 16 * 4096; i += gthreads) {
    const int bh = i >> 12, e = (i & 4095) * 2, dd = e & 63;
    unsigned* gs = (unsigned*)(p.gstate + (size_t)bh * NCH * 8192 + e);
    const float* gd = p.gdec + (size_t)bh * NCH * 64 + dd;
    float S0 = 0.f, S1 = 0.f;
    for (int j0 = 0; j0 < NCH; j0 += 13) {
      unsigned G[13]; float Da[13], Db[13];
#pragma unroll
      for (int k = 0; k < 13; k++) { G[k] = gs[(size_t)(j0 + k) * 4096]; Da[k] = gd[(j0 + k) * 64]; Db[k] = gd[(j0 + k) * 64 + 1]; }
#pragma unroll
      for (int k = 0; k < 13; k++) {
        gs[(size_t)(j0 + k) * 4096] = pack2(S0, S1);
        S0 = Da[k] * S0 + __uint_as_float(G[k] << 16);
        S1 = Db[k] * S1 + __uint_as_float(G[k] & 0xffff0000u);
      }
    }
  }
}


__device__ __forceinline__ void ph_foxsum(const Prm& p, int layer) {
  const int lane = threadIdx.x & 63;
  const int wave = (blockIdx.x * blockDim.x + threadIdx.x) >> 6;
  const int nw = (gridDim.x * blockDim.x) >> 6;
  for (int it = wave; it < 32 * NCH; it += nw) {
    const int bh = it / NCH, j = it % NCH, b = bh >> 3, h = bh & 7;
    const int t = j * 64 + lane;
    float lf = 0.f;
    if (t >= TV0) lf = logsigf_(bf2f(p.proj[(size_t)(b * LSEQ + t) * DIN + C_FF + h]) + p.b_f[layer * 8 + h]);
    lf = wave_sum(lf);
    float sq = 0.f, sk = 0.f;
    {
      const u32x4* qp = (const u32x4*)(p.proj + (size_t)(b * LSEQ + t) * DIN + C_FQ + h * 64);
      const u32x4* kp = (const u32x4*)(p.proj + (size_t)(b * LSEQ + t) * DIN + C_FK + h * 64);
#pragma unroll
      for (int i = 0; i < 8; i++) {
        const u32x4 a = qp[i], c = kp[i];
#pragma unroll
        for (int k = 0; k < 4; k++) {
          float x0 = __uint_as_float(a[k] << 16), x1 = __uint_as_float(a[k] & 0xffff0000u);
          float y0 = __uint_as_float(c[k] << 16), y1 = __uint_as_float(c[k] & 0xffff0000u);
          sq += x0 * x0 + x1 * x1; sk += y0 * y0 + y1 * y1;
        }
      }
    }
    sq = wave_max(sq); sk = wave_max(sk);
    if (lane == 0) { p.fsum[it] = lf; p.fnorm[it * 2] = sq; p.fnorm[it * 2 + 1] = sk; }
  }
}
__device__ __forceinline__ void ph_foxc(const Prm& p, int layer, int vbid, int vnblk) {
  const int lane = threadIdx.x & 63;
  const int wave = (vbid * (int)blockDim.x + (int)threadIdx.x) >> 6;
  const int nw = (vnblk * (int)blockDim.x) >> 6;
  if (vbid < 0) return;
  for (int it = wave; it < 32 * NCH; it += nw) {
    const int bh = it / NCH, j = it % NCH, b = bh >> 3, h = bh & 7;
    const float* fs = p.fsum + bh * NCH;
    float base = 0.f;
    if (lane < j) base += fs[lane];
    if (lane + 64 < j) base += fs[lane + 64];
    if (lane + 128 < j) base += fs[lane + 128];
    base = wave_sum(base);
    const int t = j * 64 + lane;
    float lf = 0.f;
    if (t >= TV0) lf = logsigf_(bf2f(p.proj[(size_t)(b * LSEQ + t) * DIN + C_FF + h]) + p.b_f[layer * 8 + h]);
#pragma unroll
    for (int off = 1; off < 64; off <<= 1) {
      float y = __shfl_up(lf, off);
      if (lane >= off) lf += y;
    }
    p.cfox[(size_t)bh * LSEQ + t] = base + lf;
  }
}

#define FS 72
#define LOG2E 1.4426950408889634f
__device__ __forceinline__ void ph_fox(const Prm& p, char* smem, const int item) {
  bf16_t* sK = (bf16_t*)smem;
  bf16_t* sVt = sK + 64 * FS;
  float* sC = (float*)(sVt + 64 * FS);
  int tid = threadIdx.x; asm volatile("" : "+v"(tid));
  const int lane = tid & 63, w = __builtin_amdgcn_readfirstlane(tid >> 6), r = lane & 31, hh = lane >> 5;
  {
    const int qb = 64 - item / 32, bh = item % 32, b = bh >> 3, h = bh & 7;
    const int q0 = qb * 128 + w * 32, tq = q0 + r;
    const bf16_t* pbase = p.proj + (size_t)b * LSEQ * DIN;
    const float* cr = p.cfox + (size_t)bh * LSEQ;
    bfx8 qf0, qf1, qf2, qf3;
    {
      const bf16_t* qp = pbase + (size_t)tq * DIN + C_FQ + h * 64 + hh * 8;
      qf0 = *(const bfx8*)(qp); qf1 = *(const bfx8*)(qp + 16); qf2 = *(const bfx8*)(qp + 32); qf3 = *(const bfx8*)(qp + 48);
    }
    float m = -1e30f, l = 0.f;
    f32x16 o0, o1;
#pragma unroll
    for (int e = 0; e < 16; e++) { o0[e] = 0.f; o1[e] = 0.f; }
    const int ktlast = 2 * qb + 1;
    int ktfirst, ktwave;
    {
      const float* fn = p.fnorm + (size_t)bh * NCH * 2;
      float kk = 0.f;
#pragma unroll
      for (int i = 0; i < 3; i++) { const int idx = lane + 64 * i; if (idx < NCH) kk = fmaxf(kk, fn[idx * 2 + 1]); }
      kk = wave_max(kk);
      const float qq = fmaxf(fn[(qb * 2) * 2], fn[(qb * 2 + 1) * 2]);
      const float bound = 0.3607f * sqrtf(qq * kk) + 160.f;
      const float ct = cr[qb * 128] * LOG2E;
      int first = ktlast;
#pragma unroll
      for (int i = 2; i >= 0; i--) {
        const int kt = 1 + lane + 64 * i;
        bool keep = false;
        if (kt <= ktlast) keep = (ct - cr[kt * 64 + 63] * LOG2E + bound) >= 0.f;
        const unsigned long long bm = __ballot(keep);
        if (bm) first = 1 + 64 * i + (int)__builtin_ctzll(bm);
      }
      ktfirst = __builtin_amdgcn_readfirstlane(first);
      const float boundw = 0.3607f * sqrtf(fn[(q0 >> 6) * 2] * kk) + 160.f;
      const float ctw = cr[q0] * LOG2E;
      int firstw = ktlast;
#pragma unroll
      for (int i = 2; i >= 0; i--) {
        const int kt = 1 + lane + 64 * i;
        bool keep = false;
        if (kt <= ktlast) keep = (ctw - cr[kt * 64 + 63] * LOG2E + boundw) >= 0.f;
        const unsigned long long bm = __ballot(keep);
        if (bm) firstw = 1 + 64 * i + (int)__builtin_ctzll(bm);
      }
      ktwave = __builtin_amdgcn_readfirstlane(firstw);
    }
    const int krow = tid >> 3, kch = tid & 7;
    const int vkey = tid & 63, vc8 = tid >> 6;
    u32x4 rk0, rk1, rv0, rv1; float rc = 0.f;
    {
      const int k0 = ktfirst * 64;
      rk0 = *(const u32x4*)(pbase + (size_t)(k0 + krow) * DIN + C_FK + h * 64 + kch * 8);
      rk1 = *(const u32x4*)(pbase + (size_t)(k0 + krow + 32) * DIN + C_FK + h * 64 + kch * 8);
      rv0 = *(const u32x4*)(pbase + (size_t)(k0 + vkey) * DIN + C_FV + h * 64 + vc8 * 8);
      rv1 = *(const u32x4*)(pbase + (size_t)(k0 + vkey) * DIN + C_FV + h * 64 + (vc8 + 4) * 8);
      if (tid < 64) rc = cr[k0 + tid];
    }
#pragma unroll 1
    for (int kt = ktfirst; kt <= ktlast; kt++) {
      const int k0 = kt * 64;
      __syncthreads();
      *(u32x4*)(sK + krow * FS + kch * 8) = rk0;
      *(u32x4*)(sK + (krow + 32) * FS + kch * 8) = rk1;
#pragma unroll
      for (int q = 0; q < 4; q++) {
        sVt[(vc8 * 8 + 2 * q) * FS + vkey] = (bf16_t)(rv0[q] & 0xffffu);
        sVt[(vc8 * 8 + 2 * q + 1) * FS + vkey] = (bf16_t)(rv0[q] >> 16);
        sVt[((vc8 + 4) * 8 + 2 * q) * FS + vkey] = (bf16_t)(rv1[q] & 0xffffu);
        sVt[((vc8 + 4) * 8 + 2 * q + 1) * FS + vkey] = (bf16_t)(rv1[q] >> 16);
      }
      if (tid < 64) sC[tid] = -rc * LOG2E;
      __syncthreads();
      if (kt < ktlast) {
        const int k1 = k0 + 64;
        rk0 = *(const u32x4*)(pbase + (size_t)(k1 + krow) * DIN + C_FK + h * 64 + kch * 8);
        rk1 = *(const u32x4*)(pbase + (size_t)(k1 + krow + 32) * DIN + C_FK + h * 64 + kch * 8);
        rv0 = *(const u32x4*)(pbase + (size_t)(k1 + vkey) * DIN + C_FV + h * 64 + vc8 * 8);
        rv1 = *(const u32x4*)(pbase + (size_t)(k1 + vkey) * DIN + C_FV + h * 64 + (vc8 + 4) * 8);
        if (tid < 64) rc = cr[k1 + tid];
      }
      if (k0 <= q0 + 31 && kt >= ktwave) {
        f32x16 s0, s1;
#pragma unroll
        for (int e = 0; e < 16; e++) { s0[e] = 0.f; s1[e] = 0.f; }
        {
          const bf16_t* ka = sK + r * FS + hh * 8;
          const bf16_t* kb = sK + (32 + r) * FS + hh * 8;
          s0 = __builtin_amdgcn_mfma_f32_32x32x16_bf16(*(const bfx8*)(ka), qf0, s0, 0, 0, 0);
          s1 = __builtin_amdgcn_mfma_f32_32x32x16_bf16(*(const bfx8*)(kb), qf0, s1, 0, 0, 0);
          s0 = __builtin_amdgcn_mfma_f32_32x32x16_bf16(*(const bfx8*)(ka + 16), qf1, s0, 0, 0, 0);
          s1 = __builtin_amdgcn_mfma_f32_32x32x16_bf16(*(const bfx8*)(kb + 16), qf1, s1, 0, 0, 0);
          s0 = __builtin_amdgcn_mfma_f32_32x32x16_bf16(*(const bfx8*)(ka + 32), qf2, s0, 0, 0, 0);
          s1 = __builtin_amdgcn_mfma_f32_32x32x16_bf16(*(const bfx8*)(kb + 32), qf2, s1, 0, 0, 0);
          s0 = __builtin_amdgcn_mfma_f32_32x32x16_bf16(*(const bfx8*)(ka + 48), qf3, s0, 0, 0, 0);
          s1 = __builtin_amdgcn_mfma_f32_32x32x16_bf16(*(const bfx8*)(kb + 48), qf3, s1, 0, 0, 0);
        }
        const bool need_mask = (kt == 1) || (k0 + 63 > q0);
        float mx = -1e30f;
        if (need_mask) {
#pragma unroll
          for (int q = 0; q < 4; q++) {
            const f32x4 c0 = *(const f32x4*)(sC + 8 * q + 4 * hh);
            const f32x4 c1 = *(const f32x4*)(sC + 32 + 8 * q + 4 * hh);
#pragma unroll
            for (int i = 0; i < 4; i++) {
              float a = fmaf(s0[4 * q + i], 0.125f * LOG2E, c0[i]);
              float bb = fmaf(s1[4 * q + i], 0.125f * LOG2E, c1[i]);
              const int key0 = k0 + 8 * q + 4 * hh + i, key1 = key0 + 32;
              a = (key0 > tq || key0 < TV0) ? -1e30f : a;
              bb = (key1 > tq || key1 < TV0) ? -1e30f : bb;
              s0[4 * q + i] = a; s1[4 * q + i] = bb;
              mx = fmaxf(mx, fmaxf(a, bb));
            }
          }
        } else {
#pragma unroll
          for (int q = 0; q < 4; q++) {
            const f32x4 c0 = *(const f32x4*)(sC + 8 * q + 4 * hh);
            const f32x4 c1 = *(const f32x4*)(sC + 32 + 8 * q + 4 * hh);
#pragma unroll
            for (int i = 0; i < 4; i++) {
              float a = fmaf(s0[4 * q + i], 0.125f * LOG2E, c0[i]);
              float bb = fmaf(s1[4 * q + i], 0.125f * LOG2E, c1[i]);
              s0[4 * q + i] = a; s1[4 * q + i] = bb;
              mx = fmaxf(mx, fmaxf(a, bb));
            }
          }
        }
        mx = fmaxf(mx, __shfl_xor(mx, 32));
        const float mn = fmaxf(m, mx);
        const float alpha = __builtin_amdgcn_exp2f(m - mn);
        m = mn;
        float ls = 0.f;
#pragma unroll
        for (int e = 0; e < 16; e++) {
          s0[e] = __builtin_amdgcn_exp2f(s0[e] - mn);
          s1[e] = __builtin_amdgcn_exp2f(s1[e] - mn);
          ls += s0[e] + s1[e];
          o0[e] *= alpha; o1[e] *= alpha;
        }
        l = l * alpha + ls;
        union { bfx8 v; unsigned u[4]; } pf;
#pragma unroll
        for (int st = 0; st < 4; st++) {
          const int i = st >> 1, sp = st & 1;
#pragma unroll
          for (int q = 0; q < 4; q++) {
            float x0 = i ? s1[8 * sp + 2 * q] : s0[8 * sp + 2 * q];
            float x1 = i ? s1[8 * sp + 2 * q + 1] : s0[8 * sp + 2 * q + 1];
            pf.u[q] = pack2(x0, x1);
          }
          const int kofs = i * 32 + 16 * sp + 4 * hh;
          union { bfx8 v; u32x2 h2[2]; } va, vb;
          va.h2[0] = *(const u32x2*)(sVt + r * FS + kofs);
          va.h2[1] = *(const u32x2*)(sVt + r * FS + kofs + 8);
          vb.h2[0] = *(const u32x2*)(sVt + (32 + r) * FS + kofs);
          vb.h2[1] = *(const u32x2*)(sVt + (32 + r) * FS + kofs + 8);
          o0 = __builtin_amdgcn_mfma_f32_32x32x16_bf16(va.v, pf.v, o0, 0, 0, 0);
          o1 = __builtin_amdgcn_mfma_f32_32x32x16_bf16(vb.v, pf.v, o1, 0, 0, 0);
        }
      }
    }
    l += __shfl_xor(l, 32);
    const float inv = __builtin_amdgcn_rcpf(l);
    bf16_t* row = p.proj + (size_t)(b * LSEQ + tq) * DIN;
    const bool valid = tq >= TV0;
#pragma unroll
    for (int q = 0; q < 4; q++) {
#pragma unroll
      for (int i = 0; i < 2; i++) {
        const int dh = i * 32 + 8 * q + 4 * hh;
        u32x2 gg = *(const u32x2*)(row + C_FG + h * 64 + dh);
        float g0 = __uint_as_float(gg[0] << 16), g1 = __uint_as_float(gg[0] & 0xffff0000u);
        float g2 = __uint_as_float(gg[1] << 16), g3 = __uint_as_float(gg[1] & 0xffff0000u);
        float y0 = (i ? o1[4 * q + 0] : o0[4 * q + 0]) * inv * siluf_(g0);
        float y1 = (i ? o1[4 * q + 1] : o0[4 * q + 1]) * inv * siluf_(g1);
        float y2 = (i ? o1[4 * q + 2] : o0[4 * q + 2]) * inv * siluf_(g2);
        float y3 = (i ? o1[4 * q + 3] : o0[4 * q + 3]) * inv * siluf_(g3);
        u32x2 o = {pack2(y0, y1), pack2(y2, y3)};
        if (!valid) { o[0] = 0u; o[1] = 0u; }
        *(u32x2*)(row + C_YF + h * 64 + dh) = o;
      }
    }
  }
}


__device__ __forceinline__ void gbar(unsigned* bar, unsigned& epoch) {
  epoch++;
  __syncthreads();
  if (threadIdx.x == 0) {
    __builtin_amdgcn_fence(__ATOMIC_RELEASE, "agent");
    const unsigned g = blockIdx.x & 15u;
    const unsigned gsz = (gridDim.x - g + 15u) >> 4;
    const unsigned old = atomicAdd(&bar[32 + 32 * g], 1u);
    if (old + 1u == epoch * gsz) {
      const unsigned o2 = atomicAdd(&bar[0], 1u);
      if (o2 + 1u == epoch * 16u) __hip_atomic_store(&bar[16], epoch, __ATOMIC_RELEASE, __HIP_MEMORY_SCOPE_AGENT);
    }
    while (__hip_atomic_load(&bar[16], __ATOMIC_RELAXED, __HIP_MEMORY_SCOPE_AGENT) < epoch) __builtin_amdgcn_s_sleep(1);
    __builtin_amdgcn_fence(__ATOMIC_ACQUIRE, "agent");
  }
  __syncthreads();
}

#define N_PHASES 15
template <int S>
__device__ __forceinline__ void run_stage(const Prm& p, int layer, float* smem) {
  if (S == 0) ph_gemm_glds<4, false>(p.r1, DM, p.wt_in + (size_t)layer * DIN * DM, DIN, DM, p.proj, DIN, (char*)smem);
  if (S == 1) ph_foxscan(p, layer);
  if (S == 3) ph_gla_naive(p, layer, smem);
  if (S == 4) ph_lru_naive_b(p, layer, smem, blockIdx.x);
  if (S == 5) ph_gemm_out(p.proj, p.wt_out + (size_t)layer * DM * DMIX, p.r1, (char*)smem);
  if (S == 6) ph_post(p, layer);
  if (S == 7) {
    ph_prenorm0(p);
    for (int l = 0; l < 2; l++) {
      ph_wtrans(p.w_in + (size_t)l * DM * DIN, DM, DIN, p.wt_in + (size_t)l * DIN * DM, smem, blockIdx.x, gridDim.x, 1, 32);
      ph_wtrans(p.w_out + (size_t)l * DMIX * DM, DMIX, DM, p.wt_out + (size_t)l * DM * DMIX, smem, blockIdx.x, gridDim.x, 1, 64);
    }
    ph_wtrans(p.w_r, 128, 128, p.wt_r, smem, blockIdx.x, gridDim.x, 16);
    ph_wtrans(p.w_i, 128, 128, p.wt_i, smem, blockIdx.x, gridDim.x, 16);
  }
}

template <int S>
__global__ void __launch_bounds__(256) k_stage(Prm p, int layer) {
  __shared__ __attribute__((aligned(16))) float smem[SMEM_BYTES / 4];
  run_stage<S>(p, layer, smem);
}

__global__ void __launch_bounds__(256, 2) k_mega(Prm p) {
  __shared__ __attribute__((aligned(16))) float smem[SMEM_BYTES / 4];
  __shared__ int sIdx;
  cg::grid_group grid = cg::this_grid();
  unsigned epoch = 0;
  if (blockIdx.x == 0) { for (int i = threadIdx.x; i < 1024; i += blockDim.x) p.bar[i] = 0u; }
  run_stage<7>(p, 0, smem);
  grid.sync();
  for (int layer = 0; layer < 2; layer++) {
    run_stage<0>(p, layer, smem); gbar(p.bar, epoch);
#if PROBE_G
    run_stage<0>(p, layer, smem); gbar(p.bar, epoch);
#endif
    ph_foxsum(p, layer);
#pragma unroll 1
    for (;;) {
      __syncthreads();
      if (threadIdx.x == 0) sIdx = (int)atomicAdd(&p.bar[640 + layer * 64], 1u);
      __syncthreads();
      const int idx = sIdx;
      if (idx >= 16 * NCH + NB * NCH * 8) break;
      if (idx < 16 * NCH) ph_gla<false>(p, layer, (char*)smem, idx);
      else ph_lru<false>(p, layer, (char*)smem, idx - 16 * NCH);
    }
    gbar(p.bar, epoch);
    {
      const int halfg = (int)gridDim.x >> 1;
      ph_foxc(p, layer, (int)blockIdx.x - halfg, (int)gridDim.x - halfg);
    }
    ph_gla_scan(p, blockIdx.x * blockDim.x + threadIdx.x, gridDim.x * blockDim.x);
    ph_lru_scan(p, ((int)gridDim.x - 1 - (int)blockIdx.x) * (int)blockDim.x + (int)threadIdx.x, gridDim.x * blockDim.x);
    gbar(p.bar, epoch);
#pragma unroll 1
    for (;;) {
      __syncthreads();
      if (threadIdx.x == 0) sIdx = (int)atomicAdd(&p.bar[640 + layer * 64 + 32], 1u);
      __syncthreads();
      const int idx = sIdx;
      if (idx >= 32 * 65 + 16 * NCH + NB * NCH * 8) break;
      if (idx < 32 * 65) ph_fox(p, (char*)smem, idx);
      else if (idx < 32 * 65 + 16 * NCH) ph_gla<true>(p, layer, (char*)smem, idx - 32 * 65);
      else ph_lru<true>(p, layer, (char*)smem, idx - 32 * 65 - 16 * NCH);
    }
    gbar(p.bar, epoch);
    run_stage<5>(p, layer, smem); gbar(p.bar, epoch);
#if PROBE_G
    run_stage<5>(p, layer, smem); gbar(p.bar, epoch);
#endif
    run_stage<6>(p, layer, smem);
    if (layer == 0) gbar(p.bar, epoch);
  }
}


extern "C" void kernel_launch(void* const* d_in, const int* in_sizes, int n_in, void* d_out, int out_size,
                              void* d_ws, size_t ws_size, hipStream_t stream) {
  Prm p{};
  p.x = (const float*)d_in[0]; p.meta = (const float*)d_in[1]; p.pre_g = (const float*)d_in[2];
  p.w_in = (const float*)d_in[3]; p.b_f = (const float*)d_in[4]; p.w_a2 = (const float*)d_in[5];
  p.b_a = (const float*)d_in[6]; p.gla_g = (const float*)d_in[7]; p.conv_w = (const float*)d_in[8];
  p.conv_b = (const float*)d_in[9]; p.w_r = (const float*)d_in[10]; p.b_r = (const float*)d_in[11];
  p.w_i = (const float*)d_in[12]; p.b_i = (const float*)d_in[13]; p.lam = (const float*)d_in[14];
  p.w_out = (const float*)d_in[15]; p.post_g = (const float*)d_in[16];
  p.out = (float*)d_out;
  char* ws = (char*)d_ws;
  size_t off = 0;
  p.proj = (bf16_t*)(ws + off); off += (size_t)NTOK * DIN * 2;
  p.r1 = (bf16_t*)(ws + off); off += (size_t)NTOK * DM * 2;
  p.cfox = (float*)(ws + off); off += (size_t)NB * 8 * LSEQ * 4;
  p.hmeta = (float*)(ws + off); off += (size_t)NB * 16 * DM * 4;
  p.wt_in = (bf16_t*)(ws + off); off += (size_t)2 * DIN * DM * 2;
  p.wt_out = (bf16_t*)(ws + off); off += (size_t)2 * DM * DMIX * 2;
  p.wt_r = (bf16_t*)(ws + off); off += (size_t)2 * 8 * 128 * 128 * 2;
  p.wt_i = (bf16_t*)(ws + off); off += (size_t)2 * 8 * 128 * 128 * 2;
  p.lruP = (float*)(ws + off); off += (size_t)NB * 130 * 1024 * 4;
  p.lruH = (float*)(ws + off); off += (size_t)NB * 130 * 1024 * 4;
  p.gstate = (bf16_t*)p.r1;
  p.gdec = (float*)(ws + off); off += (size_t)16 * 130 * 64 * 4;
  p.bar = (unsigned*)(ws + off); off += 4096;
  p.fsum = (float*)(ws + off); off += 32 * 130 * 4 + 128;
  p.fnorm = (float*)(ws + off); off += 32 * 130 * 2 * 4 + 128;
  p.gB = (float*)(ws + off); off += (size_t)16 * 130 * 64 * 64 * 4;
#if MEGA
  static int grid_blocks = 0;
  if (!grid_blocks) {
    int dev = 0, cus = 0, per_cu = 0;
    hipGetDevice(&dev);
    hipDeviceGetAttribute(&cus, hipDeviceAttributeMultiprocessorCount, dev);
    hipOccupancyMaxActiveBlocksPerMultiprocessor(&per_cu, k_mega, 256, 0);
    if (per_cu > 4) per_cu = 4;
    grid_blocks = cus * per_cu;
  }
  void* args[] = {&p};
  hipError_t e = hipLaunchCooperativeKernel((void*)k_mega, dim3(grid_blocks), dim3(256), args, 0, stream);
  if (e != hipSuccess) fprintf(stderr, "cooperative launch failed: %s (grid %d)\n", hipGetErrorString(e), grid_blocks);
#else
  k_stage<7><<<1024, 256, 0, stream>>>(p, 0);
  for (int layer = 0; layer < 2; layer++) {
    k_stage<0><<<2048, 256, 0, stream>>>(p, layer);
    k_stage<1><<<8, 256, 0, stream>>>(p, layer);
    k_stage<2><<<NB * 8 * 33, 256, 0, stream>>>(p, layer);
    k_stage<3><<<16, 256, 0, stream>>>(p, layer);
    k_stage<4><<<32, 256, 0, stream>>>(p, layer);
    k_stage<5><<<2048, 256, 0, stream>>>(p, layer);
    k_stage<6><<<1024, 256, 0, stream>>>(p, layer);
  }
#endif
}
```
